# Optimizing an MI355X kernel written in HIP

```python
import jax, jax.numpy as jnp
from jax import lax
import numpy as np

D_MODEL = 2048
BATCH = 4
SEQ = 8192
DEPTH = 1

HEAD_DIM = 64
N_FOX_HEADS = 16
N_DIL_HEADS = 16
FOX_WIDTH = N_FOX_HEADS * HEAD_DIM
DIL_WIDTH = N_DIL_HEADS * HEAD_DIM
MIX_WIDTH = FOX_WIDTH + DIL_WIDTH
ROPE_THETA = 500000.0
ROPE_DIM = HEAD_DIM // 4
DILATED_PAIRS = ((128, 1), (512, 4), (2048, 16))
Q_BLOCK = 128
PEER_HEADS = 8
PEER_N_KEYS = 128
PEER_N_EXPERTS = PEER_N_KEYS * PEER_N_KEYS
PEER_KEY_DIM = 256
PEER_HALF = PEER_KEY_DIM // 2
PEER_TOPK = 16
PEER_TOKEN_BLOCK = 128
RMS_EPS = 1e-6
IN_COLS = 3 * FOX_WIDTH + N_FOX_HEADS + 3 * DIL_WIDTH

kernel_name = 'hybrid_fox_dilated_peer_block'


def rms_norm(x, g):
    xf = x.astype(jnp.float32)
    y = xf * lax.rsqrt(jnp.mean(xf * xf, axis=-1, keepdims=True) + RMS_EPS)
    return y.astype(x.dtype) * g


def partial_rope(x, pos):
    inv = ROPE_THETA ** (-jnp.arange(0, ROPE_DIM, 2, dtype=jnp.float32) / ROPE_DIM)
    ang = pos.astype(jnp.float32)[:, None] * inv[None, :]
    cos = jnp.cos(ang)[None, :, None, :].astype(x.dtype)
    sin = jnp.sin(ang)[None, :, None, :].astype(x.dtype)
    xr, xp = x[..., :ROPE_DIM], x[..., ROPE_DIM:]
    x1, x2 = xr[..., :ROPE_DIM // 2], xr[..., ROPE_DIM // 2:]
    rot = jnp.concatenate([x1 * cos - x2 * sin, x2 * cos + x1 * sin], axis=-1)
    return jnp.concatenate([rot, xp], axis=-1)


def forgetting_attention(q, k, v, f_logit):
    B, S, H, hd = q.shape
    nb = S // Q_BLOCK
    log_f = jax.nn.log_sigmoid(f_logit.astype(jnp.float32))
    c = jnp.cumsum(log_f, axis=1).transpose(0, 2, 1)
    qh = q.transpose(0, 2, 1, 3) * (hd ** -0.5)
    kh = k.transpose(0, 2, 1, 3)
    vh = v.transpose(0, 2, 1, 3)
    q_blocks = qh.reshape(B, H, nb, Q_BLOCK, hd).transpose(2, 0, 1, 3, 4)
    c_blocks = c.reshape(B, H, nb, Q_BLOCK).transpose(2, 0, 1, 3)
    starts = jnp.arange(nb, dtype=jnp.int32) * Q_BLOCK
    k_pos = jnp.arange(S, dtype=jnp.int32)

    def block(args):
        qb, cb, s0 = args
        logits = jnp.einsum('bhqd,bhkd->bhqk', qb, kh).astype(jnp.float32)
        logits = logits + (cb[..., :, None] - c[..., None, :])
        q_pos = s0 + jnp.arange(Q_BLOCK, dtype=jnp.int32)
        mask = k_pos[None, :] <= q_pos[:, None]
        logits = jnp.where(mask, logits, -jnp.inf)
        p = jax.nn.softmax(logits, axis=-1).astype(vh.dtype)
        return jnp.einsum('bhqk,bhkd->bhqd', p, vh)

    o = lax.map(block, (q_blocks, c_blocks, starts))
    return o.transpose(1, 0, 3, 2, 4).reshape(B, S, H, hd)


def dilated_pattern(q, k, v, window, dilation):
    B, S, H, hd = q.shape
    span = window // dilation
    unit = dilation * Q_BLOCK
    s_pad = -(-S // unit) * unit
    L = s_pad // dilation
    nb = L // Q_BLOCK
    pad = ((0, 0), (0, s_pad - S), (0, 0), (0, 0))

    def to_sub(t):
        t = jnp.pad(t, pad).reshape(B, L, dilation, H, hd)
        return t.transpose(0, 2, 3, 1, 4).reshape(B, dilation, H, nb, Q_BLOCK, hd)

    def with_prev(t):
        prev = jnp.pad(t, ((0, 0), (0, 0), (0, 0), (1, 0), (0, 0), (0, 0)))[:, :, :, :-1]
        return jnp.concatenate([prev, t], axis=-2)

    qs = to_sub(q)
    kk = with_prev(to_sub(k))
    vv = with_prev(to_sub(v))
    logits = jnp.einsum('brhnqd,brhnkd->brhnqk', qs, kk).astype(jnp.float32) * (hd ** -0.5)
    qi = jnp.arange(Q_BLOCK)[:, None]
    kj = jnp.arange(2 * Q_BLOCK)[None, :]
    dist = qi + Q_BLOCK - kj
    band = (dist >= 0) & (dist <= span)
    has_prev = (jnp.arange(nb)[:, None, None] > 0) | (kj[None] >= Q_BLOCK)
    mask = band[None] & has_prev
    logits = jnp.where(mask, logits, -jnp.inf)
    m = jnp.max(logits, axis=-1, keepdims=True)
    e = jnp.exp(logits - m)
    den = jnp.sum(e, axis=-1, keepdims=True)
    o = jnp.einsum('brhnqk,brhnkd->brhnqd', (e / den).astype(v.dtype), vv)
    lse = (m + jnp.log(den))[..., 0]
    o = o.reshape(B, dilation, H, L, hd).transpose(0, 3, 1, 2, 4).reshape(B, s_pad, H, hd)[:, :S]
    lse = lse.reshape(B, dilation, H, L).transpose(0, 3, 1, 2).reshape(B, s_pad, H)[:, :S]
    return o, lse


def dilated_attention(q, k, v):
    outs = []
    lses = []
    for window, dilation in DILATED_PAIRS:
        o, lse = dilated_pattern(q, k, v, window, dilation)
        outs.append(o)
        lses.append(lse)
    wts = jax.nn.softmax(jnp.stack(lses, axis=0), axis=0)
    return jnp.sum(wts[..., None].astype(q.dtype) * jnp.stack(outs, axis=0), axis=0)


def peer(x, w_query, sub_keys, expert_down, expert_up):
    B, S, D = x.shape
    T = B * S
    xt = x.reshape(T, D)
    q = (xt @ w_query).reshape(T, PEER_HEADS, 2, PEER_HALF)
    scores = jnp.einsum('thpc,hpnc->thpn', q, sub_keys).astype(jnp.float32)
    vals, idx = lax.top_k(scores, PEER_TOPK)
    cand = (vals[..., 0, :, None] + vals[..., 1, None, :]).reshape(T, PEER_HEADS, PEER_TOPK * PEER_TOPK)
    top_vals, top_c = lax.top_k(cand, PEER_TOPK)
    i1 = jnp.take_along_axis(idx[..., 0, :], top_c // PEER_TOPK, axis=-1)
    i2 = jnp.take_along_axis(idx[..., 1, :], top_c % PEER_TOPK, axis=-1)
    experts = (i1 * PEER_N_KEYS + i2).reshape(T, PEER_HEADS * PEER_TOPK)
    gates = jax.nn.softmax(top_vals, axis=-1).reshape(T, PEER_HEADS * PEER_TOPK).astype(x.dtype)
    nc = T // PEER_TOKEN_BLOCK

    def block(args):
        xc, ec, gc = args
        u = jnp.take(expert_down, ec, axis=0)
        hdn = jax.nn.gelu(jnp.einsum('ted,td->te', u, xc))
        vsel = jnp.take(expert_up, ec, axis=0)
        return jnp.einsum('te,ted->td', gc * hdn, vsel)

    y = lax.map(block, (xt.reshape(nc, PEER_TOKEN_BLOCK, D),
                        experts.reshape(nc, PEER_TOKEN_BLOCK, PEER_HEADS * PEER_TOPK),
                        gates.reshape(nc, PEER_TOKEN_BLOCK, PEER_HEADS * PEER_TOPK)))
    return y.reshape(B, S, D)


def setup_inputs(seed: int = 0) -> dict:
    key = jax.random.key(seed)
    ks = jax.random.split(key, 16)
    f32 = jnp.float32
    x = jax.random.normal(ks[0], (BATCH, SEQ, D_MODEL), f32)
    attn_norm_gain = 1.0 + 0.02 * jax.random.normal(ks[1], (DEPTH, D_MODEL), f32)
    w_in = jax.random.normal(ks[2], (DEPTH, D_MODEL, IN_COLS), f32) * D_MODEL ** -0.5
    forget_bias = jax.random.uniform(ks[3], (DEPTH, N_FOX_HEADS), f32, 1.0, 6.0)
    fox_out_gain = 1.0 + 0.02 * jax.random.normal(ks[4], (DEPTH, FOX_WIDTH), f32)
    dil_out_gain = 1.0 + 0.02 * jax.random.normal(ks[5], (DEPTH, DIL_WIDTH), f32)
    w_out = jax.random.normal(ks[6], (DEPTH, MIX_WIDTH, D_MODEL), f32) * MIX_WIDTH ** -0.5
    ffn_norm_gain = 1.0 + 0.02 * jax.random.normal(ks[7], (DEPTH, D_MODEL), f32)
    peer_query = jax.random.normal(ks[8], (DEPTH, D_MODEL, PEER_HEADS * PEER_KEY_DIM), f32) * D_MODEL ** -0.5
    peer_sub_keys = jax.random.normal(ks[9], (DEPTH, PEER_HEADS, 2, PEER_N_KEYS, PEER_HALF), f32) * PEER_HALF ** -0.5
    peer_down = jax.random.normal(ks[10], (DEPTH, PEER_N_EXPERTS, D_MODEL), f32) * D_MODEL ** -0.5
    peer_up = jax.random.normal(ks[11], (DEPTH, PEER_N_EXPERTS, D_MODEL), f32) * (PEER_HEADS * PEER_TOPK) ** -0.5
    final_norm_gain = 1.0 + 0.02 * jax.random.normal(ks[12], (D_MODEL,), f32)
    return {'x': x, 'attn_norm_gain': attn_norm_gain, 'w_in': w_in, 'forget_bias': forget_bias,
            'fox_out_gain': fox_out_gain, 'dil_out_gain': dil_out_gain, 'w_out': w_out,
            'ffn_norm_gain': ffn_norm_gain, 'peer_query': peer_query, 'peer_sub_keys': peer_sub_keys,
            'peer_down': peer_down, 'peer_up': peer_up, 'final_norm_gain': final_norm_gain}


def reference(x, attn_norm_gain, w_in, forget_bias, fox_out_gain, dil_out_gain, w_out,
              ffn_norm_gain, peer_query, peer_sub_keys, peer_down, peer_up, final_norm_gain):
    B, S, _ = x.shape
    pos = jnp.arange(S, dtype=jnp.int32)
    splits = [FOX_WIDTH, 2 * FOX_WIDTH, 3 * FOX_WIDTH, 3 * FOX_WIDTH + N_FOX_HEADS,
              3 * FOX_WIDTH + N_FOX_HEADS + DIL_WIDTH, 3 * FOX_WIDTH + N_FOX_HEADS + 2 * DIL_WIDTH]
    h = x
    for layer in range(DEPTH):
        xn = rms_norm(h, attn_norm_gain[layer])
        proj = xn @ w_in[layer]
        fq, fk, fv, fg, dq, dk, dv = jnp.split(proj, splits, axis=-1)
        heads_f = (B, S, N_FOX_HEADS, HEAD_DIM)
        heads_d = (B, S, N_DIL_HEADS, HEAD_DIM)
        fox_o = forgetting_attention(fq.reshape(heads_f), fk.reshape(heads_f), fv.reshape(heads_f),
                                     fg + forget_bias[layer])
        dq = partial_rope(dq.reshape(heads_d), pos)
        dk = partial_rope(dk.reshape(heads_d), pos)
        dil_o = dilated_attention(dq, dk, dv.reshape(heads_d))
        mixed = jnp.concatenate([rms_norm(fox_o.reshape(B, S, FOX_WIDTH), fox_out_gain[layer]),
                                 rms_norm(dil_o.reshape(B, S, DIL_WIDTH), dil_out_gain[layer])], axis=-1)
        h = h + mixed @ w_out[layer]
        hn = rms_norm(h, ffn_norm_gain[layer])
        h = h + peer(hn, peer_query[layer], peer_sub_keys[layer], peer_down[layer], peer_up[layer])
    return rms_norm(h, final_norm_gain)
```

```cpp
#include <hip/hip_runtime.h>
#include <hip/hip_cooperative_groups.h>
#include <cstdio>
#include <cstdint>
#include <cmath>
namespace cg = cooperative_groups;

#define DI __device__ __forceinline__
typedef unsigned short u16;
typedef short bf16x8 __attribute__((ext_vector_type(8)));
typedef short s16x4 __attribute__((ext_vector_type(4)));
typedef float f32x4 __attribute__((ext_vector_type(4)));
typedef float f32x2 __attribute__((ext_vector_type(2)));
typedef unsigned u32x4 __attribute__((ext_vector_type(4)));
typedef unsigned u32x2 __attribute__((ext_vector_type(2)));
typedef __bf16 bf16v2 __attribute__((ext_vector_type(2)));

constexpr int DM = 2048, NB = 4, SEQ = 8192, T = NB * SEQ, NH = 16;
constexpr int NEXP = 16384;
constexpr float LOG2E = 1.4426950408889634f;
constexpr float EPS = 1e-6f;
constexpr int LDS_BYTES = 73728;

struct Params {
  const float *x, *attn_gain, *w_in, *forget_bias, *fox_gain, *dil_gain, *w_out, *ffn_gain, *peer_query, *sub_keys, *peer_down, *peer_up, *final_gain;
  float* out;
  u16 *xn, *winT, *woutT, *wqT, *keysb;
  unsigned char *down8, *up8;
  float *dscale, *uscale;
  float* rope;
  u16 *fq, *fk, *fvt, *dq, *dk, *dv;
  float* logf;
  u16 *foxo, *dilop;
  float* lse;
  u16* h1bf;
  float* part2;
  int* experts;
  float* gates;
  float* qkmax;
  int* ctr;
  unsigned* xbar;
  float inv_freq[8];
};

DI unsigned pk2(float a, float b) { f32x2 v = {a, b}; bf16v2 r = __builtin_convertvector(v, bf16v2); return __builtin_bit_cast(unsigned, r); }
DI float bflo(unsigned u) { return __uint_as_float(u << 16); }
DI float bfhi(unsigned u) { return __uint_as_float(u & 0xffff0000u); }
DI float wave_sum(float v) {
  v += __shfl_xor(v, 32); v += __shfl_xor(v, 16); v += __shfl_xor(v, 8); v += __shfl_xor(v, 4); v += __shfl_xor(v, 2); v += __shfl_xor(v, 1); return v;
}
#define MFMA16(a, b, c) __builtin_amdgcn_mfma_f32_16x16x32_bf16((a), (b), (c), 0, 0, 0)

DI void sincos_acc(float a, float& s, float& c) {
  const double x = (double)a;
  const double n = rint(x * 0.63661977236758134308);
  const double r = x - n * 1.57079632679489661923;
  const int q = ((int)n) & 3;
  const double r2 = r * r;
  const double sn = r * (1.0 + r2 * (-1.0 / 6.0 + r2 * (1.0 / 120.0 + r2 * (-1.0 / 5040.0 + r2 * (1.0 / 362880.0 + r2 * (-1.0 / 39916800.0))))));
  const double cs = 1.0 + r2 * (-0.5 + r2 * (1.0 / 24.0 + r2 * (-1.0 / 720.0 + r2 * (1.0 / 40320.0 + r2 * (-1.0 / 3628800.0 + r2 * (1.0 / 479001600.0))))));
  double so, co;
  if (q == 0) { so = sn; co = cs; } else if (q == 1) { so = cs; co = -sn; } else if (q == 2) { so = -sn; co = -cs; } else { so = -cs; co = sn; }
  s = (float)so; c = (float)co;
}

template <int MODE>
DI void transpose_weights(const float* __restrict__ src, int ldsrc, u16* __restrict__ dst, int ntn, const float* __restrict__ scale, float* tile) {
  const int tid = threadIdx.x;
  for (int u = blockIdx.x; u < ntn * 32; u += gridDim.x) {
    const int tnn = u >> 5, tk = u & 31;
    {
      const int c = tid & 63, r0 = tid >> 6;
      const int n = tnn * 64 + c;
      int sc;
      if (MODE == 0) sc = n;
      else sc = (n < 3072) ? n : (n < 6144 ? n + 16 : (n < 6160 ? 3072 + (n - 6144) : -1));
#pragma unroll
      for (int i = 0; i < 16; ++i) {
        const int r = r0 + 4 * i, k = tk * 64 + r;
        float v = 0.f;
        if (sc >= 0) { v = src[(size_t)k * ldsrc + sc]; if (scale) v *= scale[k]; }
        tile[r * 65 + c] = v;
      }
    }
    __syncthreads();
    {
      const int k2 = (tid & 31) * 2, n0 = tid >> 5;
#pragma unroll
      for (int i = 0; i < 8; ++i) {
        const int n = n0 + 8 * i;
        const unsigned w = pk2(tile[k2 * 65 + n], tile[(k2 + 1) * 65 + n]);
        *(unsigned*)(dst + (size_t)(tnn * 64 + n) * 2048 + tk * 64 + k2) = w;
      }
    }
    __syncthreads();
  }
}

DI void convert_f32_bf16(const float* __restrict__ src, u16* __restrict__ dst, size_t n4) {
  const size_t stride = (size_t)gridDim.x * 256;
  for (size_t i = (size_t)blockIdx.x * 256 + threadIdx.x; i < n4; i += stride) {
    const float4 v = ((const float4*)src)[i];
    u32x2 w; w.x = pk2(v.x, v.y); w.y = pk2(v.z, v.w);
    ((u32x2*)dst)[i] = w;
  }
}


DI float wave_max(float v) {
  v = fmaxf(v, __shfl_xor(v, 32)); v = fmaxf(v, __shfl_xor(v, 16)); v = fmaxf(v, __shfl_xor(v, 8)); v = fmaxf(v, __shfl_xor(v, 4)); v = fmaxf(v, __shfl_xor(v, 2)); v = fmaxf(v, __shfl_xor(v, 1)); return v;
}
typedef float f32x32 __attribute__((ext_vector_type(32)));
typedef unsigned u32x6 __attribute__((ext_vector_type(6)));
constexpr int ROWB = 1536;
DI unsigned e2m3_code(float x) {
  const float a = fabsf(x);
  const float c = a < 2.0f ? rintf(a * 8.0f) : (a < 4.0f ? 16.0f + rintf((a - 2.0f) * 4.0f) : 24.0f + rintf((a - 4.0f) * 2.0f));
  const unsigned u = (unsigned)fminf(c, 31.0f);
  return u | (x < 0.f ? 32u : 0u);
}
DI void convert_rows_fp6(const float* __restrict__ src, unsigned char* __restrict__ dst, float* __restrict__ scl) {
  const int tid = threadIdx.x, lane = tid & 63, wid = tid >> 6;
  const int gw = blockIdx.x * 4 + wid, nw = gridDim.x * 4;
  for (int row = gw; row < NEXP; row += nw) {
    f32x4 v[8]; float am = 0.f;
#pragma unroll
    for (int j = 0; j < 8; ++j) {
      v[j] = *(const f32x4*)(src + (size_t)row * DM + 256 * j + 4 * lane);
      am = fmaxf(am, fmaxf(fmaxf(fabsf(v[j][0]), fabsf(v[j][1])), fmaxf(fabsf(v[j][2]), fabsf(v[j][3]))));
    }
    am = wave_max(am);
    const float inv = am > 0.f ? 7.5f / am : 0.f;
    unsigned c[32];
#pragma unroll
    for (int j = 0; j < 8; ++j)
#pragma unroll
      for (int q = 0; q < 4; ++q) c[4 * j + q] = e2m3_code(v[j][q] * inv);
    unsigned w[6];
#pragma unroll
    for (int g = 0; g < 2; ++g) {
      const unsigned* cc = c + 16 * g;
      w[3 * g + 0] = cc[0] | (cc[1] << 6) | (cc[2] << 12) | (cc[3] << 18) | (cc[4] << 24) | (cc[5] << 30);
      w[3 * g + 1] = (cc[5] >> 2) | (cc[6] << 4) | (cc[7] << 10) | (cc[8] << 16) | (cc[9] << 22) | (cc[10] << 28);
      w[3 * g + 2] = (cc[10] >> 4) | (cc[11] << 2) | (cc[12] << 8) | (cc[13] << 14) | (cc[14] << 20) | (cc[15] << 26);
    }
    u32x2* d2 = (u32x2*)(dst + (size_t)row * ROWB + lane * 24);
    d2[0] = (u32x2){w[0], w[1]}; d2[1] = (u32x2){w[2], w[3]}; d2[2] = (u32x2){w[4], w[5]};
    if (lane == 0) scl[row] = am * (1.0f / 7.5f);
  }
}

DI void phase_prep(const Params& p, char* lds) {
  const int tid = threadIdx.x, lane = tid & 63, wid = tid >> 6;
  const int gw = blockIdx.x * 4 + wid, nw = gridDim.x * 4;
  for (int t = gw; t < T; t += nw) {
    const float4* xr = (const float4*)(p.x + (size_t)t * DM);
    float4 v[8]; float ss = 0.f;
#pragma unroll
    for (int i = 0; i < 8; ++i) { v[i] = xr[i * 64 + lane]; ss += v[i].x * v[i].x + v[i].y * v[i].y + v[i].z * v[i].z + v[i].w * v[i].w; }
    ss = wave_sum(ss);
    const float rs = rsqrtf(ss * (1.0f / DM) + EPS);
#pragma unroll
    for (int i = 0; i < 8; ++i) {
      const float4 g = ((const float4*)p.attn_gain)[i * 64 + lane];
      u32x2 w; w.x = pk2(v[i].x * rs * g.x, v[i].y * rs * g.y); w.y = pk2(v[i].z * rs * g.z, v[i].w * rs * g.w);
      *(u32x2*)(p.xn + (size_t)t * DM + (i * 64 + lane) * 4) = w;
    }
  }
  transpose_weights<1>(p.w_in, 6160, p.winT, 98, nullptr, (float*)lds);
  transpose_weights<0>(p.w_out, 2048, p.woutT, 32, nullptr, (float*)lds);
  transpose_weights<0>(p.peer_query, 2048, p.wqT, 32, p.ffn_gain, (float*)lds);
  convert_f32_bf16(p.sub_keys, p.keysb, (size_t)8 * 2 * 128 * 128 / 4);
  convert_rows_fp6(p.peer_down, p.down8, p.dscale);
  convert_rows_fp6(p.peer_up, p.up8, p.uscale);
  if (blockIdx.x == 0) { if (tid < 128) p.qkmax[tid] = 0.f; if (tid < 8) p.ctr[tid] = 0; }
  for (int i = blockIdx.x * 256 + tid; i < SEQ * 8; i += gridDim.x * 256) {
    const int s = i >> 3, f = i & 7;
    const float ang = (float)s * p.inv_freq[f];
    float sn, cs; sincos_acc(ang, sn, cs);
    p.rope[2 * i] = cs; p.rope[2 * i + 1] = sn;
  }
}

#define LAS __attribute__((address_space(3)))
template <bool SWAP, class Epi>
DI void gemm_tile(const u16* __restrict__ A, const u16* __restrict__ Bt, int tm, int tn, u16* sa, u16* sb, const Epi& epi) {
  constexpr int K = 2048, ABUF = 256 * 32, BBUF = 128 * 32, NP = SWAP ? 4 : 8, NQ = SWAP ? 8 : 4;
  const int tid = threadIdx.x, lane = tid & 63, wid = __builtin_amdgcn_readfirstlane(tid >> 6), wm = wid >> 1, wn = wid & 1, fr = lane & 15, quad = lane >> 4;
  const u16* ga = A + (size_t)(tm * 256) * K;
  const u16* gb = Bt + (size_t)(tn * 128) * K;
  int goffA[4], goffB[2];
#pragma unroll
  for (int q = 0; q < 4; ++q) { const int r = wid * 64 + q * 16 + (lane >> 2); goffA[q] = r * K + (((lane & 3) ^ ((r >> 2) & 3)) * 8); }
#pragma unroll
  for (int q = 0; q < 2; ++q) { const int r = wid * 32 + q * 16 + (lane >> 2); goffB[q] = r * K + (((lane & 3) ^ ((r >> 2) & 3)) * 8); }
  f32x4 acc[NP][NQ];
#pragma unroll
  for (int i = 0; i < NP; ++i)
#pragma unroll
    for (int j = 0; j < NQ; ++j) acc[i][j] = (f32x4){0.f, 0.f, 0.f, 0.f};
  const int swz = (quad ^ ((fr >> 2) & 3)) * 8;
  const u16* sp = SWAP ? (sb + (wn * 64 + fr) * 32 + swz) : (sa + (wm * 128 + fr) * 32 + swz);
  const u16* sq = SWAP ? (sa + (wm * 128 + fr) * 32 + swz) : (sb + (wn * 64 + fr) * 32 + swz);
  constexpr int PBUF = SWAP ? BBUF : ABUF, QBUF = SWAP ? ABUF : BBUF;
  auto issue = [&](int k0, int buf) {
#pragma unroll
    for (int q = 0; q < 4; ++q) __builtin_amdgcn_global_load_lds((const unsigned*)(ga + goffA[q] + k0), (LAS unsigned*)(sa + buf * ABUF + (wid * 64 + q * 16) * 32), 16, 0, 0);
#pragma unroll
    for (int q = 0; q < 2; ++q) __builtin_amdgcn_global_load_lds((const unsigned*)(gb + goffB[q] + k0), (LAS unsigned*)(sb + buf * BBUF + (wid * 32 + q * 16) * 32), 16, 0, 0);
  };
  issue(0, 0);
  __syncthreads();
  for (int kt = 0; kt < K / 32; ++kt) {
    const int cur = kt & 1;
    if (kt + 1 < K / 32) issue((kt + 1) * 32, cur ^ 1);
    bf16x8 pf[NP], qf[NQ];
#pragma unroll
    for (int i = 0; i < NP; ++i) pf[i] = *(const bf16x8*)(sp + cur * PBUF + 16 * i * 32);
#pragma unroll
    for (int j = 0; j < NQ; ++j) qf[j] = *(const bf16x8*)(sq + cur * QBUF + 16 * j * 32);
    __builtin_amdgcn_s_setprio(1);
#pragma unroll
    for (int i = 0; i < NP; ++i)
#pragma unroll
      for (int j = 0; j < NQ; ++j) acc[i][j] = MFMA16(pf[i], qf[j], acc[i][j]);
    __builtin_amdgcn_s_setprio(0);
    __syncthreads();
  }
  epi.template run<SWAP>(acc, tm, tn, wm, wn, fr, quad);
}

DI float log_sigmoid(float v) { return v >= 0.f ? -log1pf(expf(-v)) : v - log1pf(expf(v)); }

DI u32x4 pair16(u32x2 e, u32x2 o, int quad, int ip, int* col) {
  const bool odd = quad & 1;
  const u32x2 send = odd ? e : o, keep = odd ? o : e;
  u32x2 recv; recv.x = (unsigned)__shfl_xor((int)send.x, 16); recv.y = (unsigned)__shfl_xor((int)send.y, 16);
  *col = 16 * (2 * ip + (odd ? 1 : 0)) + 8 * (quad >> 1);
  return odd ? (u32x4){recv.x, recv.y, keep.x, keep.y} : (u32x4){keep.x, keep.y, recv.x, recv.y};
}

struct EpiQKV {
  const Params* p;
  template <bool SWAP>
  DI void run(const f32x4 (&acc)[SWAP ? 4 : 8][SWAP ? 8 : 4], int tm, int tn, int wm, int wn, int fr, int quad) const {
    const Params& P = *p;
    const int gcol = tn * 128 + wn * 64, grp = gcol >> 10, head = (gcol & 1023) >> 6;
    const int m0 = tm * 256 + wm * 128, b = m0 >> 13, s0 = m0 & 8191, bh = b * NH + head;
    if constexpr (!SWAP) {
#pragma unroll
      for (int ip = 0; ip < 4; ++ip)
#pragma unroll
        for (int j = 0; j < 4; ++j) {
          u32x2 e, o; e.x = pk2(acc[2 * ip][j][0], acc[2 * ip][j][1]); e.y = pk2(acc[2 * ip][j][2], acc[2 * ip][j][3]);
          o.x = pk2(acc[2 * ip + 1][j][0], acc[2 * ip + 1][j][1]); o.y = pk2(acc[2 * ip + 1][j][2], acc[2 * ip + 1][j][3]);
          int col; const u32x4 w = pair16(e, o, quad, ip, &col);
          *(u32x4*)(P.fvt + ((size_t)(bh * 64 + 16 * j + fr)) * SEQ + s0 + col) = w;
        }
    } else {
      if (grp == 6) {
        if (wn == 0) {
#pragma unroll
          for (int j = 0; j < 8; ++j)
#pragma unroll
            for (int r = 0; r < 4; ++r) {
              const int h = quad * 4 + r;
              const float v = acc[0][j][r] + P.forget_bias[h];
              P.logf[(size_t)(b * NH + h) * SEQ + s0 + 16 * j + fr] = log_sigmoid(v) * LOG2E;
            }
        }
      } else {
        u16* dst = grp == 0 ? P.fq : (grp == 1 ? P.fk : (grp == 3 ? P.dq : (grp == 4 ? P.dk : P.dv)));
        const float scale = (grp == 0 || grp == 3) ? 0.125f * LOG2E : 1.0f;
        const bool rope = (grp == 3 || grp == 4);
        float best = 0.f;
#pragma unroll
        for (int j = 0; j < 8; ++j) {
          const int s = s0 + 16 * j + fr;
          float nrm = 0.f;
          u32x2 pc[4];
#pragma unroll
          for (int i = 0; i < 4; ++i) {
            f32x4 v = acc[i][j];
            if (i == 0 && rope) {
              const f32x4* rp = (const f32x4*)(P.rope + ((size_t)s * 8 + (quad & 1) * 4) * 2);
              const f32x4 cs01 = rp[0], cs23 = rp[1];
              const float cs[4] = {cs01[0], cs01[2], cs23[0], cs23[2]};
              const float sn[4] = {cs01[1], cs01[3], cs23[1], cs23[3]};
#pragma unroll
              for (int r = 0; r < 4; ++r) {
                const float pr = __shfl_xor(v[r], 32);
                v[r] = quad < 2 ? v[r] * cs[r] - pr * sn[r] : v[r] * cs[r] + pr * sn[r];
              }
            }
            v *= scale;
            nrm += v[0] * v[0] + v[1] * v[1] + v[2] * v[2] + v[3] * v[3];
            pc[i].x = pk2(v[0], v[1]); pc[i].y = pk2(v[2], v[3]);
          }
#pragma unroll
          for (int ip = 0; ip < 2; ++ip) {
            int col; const u32x4 w = pair16(pc[2 * ip], pc[2 * ip + 1], quad, ip, &col);
            *(u32x4*)(dst + ((size_t)bh * SEQ + s) * 64 + col) = w;
          }
          if (grp < 2) { nrm += __shfl_xor(nrm, 16); nrm += __shfl_xor(nrm, 32); best = fmaxf(best, nrm); }
        }
        if (grp < 2) {
          best = fmaxf(best, __shfl_xor(best, 1)); best = fmaxf(best, __shfl_xor(best, 2)); best = fmaxf(best, __shfl_xor(best, 4)); best = fmaxf(best, __shfl_xor(best, 8));
          if ((threadIdx.x & 63) == 0) atomicMax((unsigned*)P.qkmax + grp * 64 + bh, __float_as_uint(best));
        }
      }
    }
  }
};

struct EpiOut {
  const Params* p;
  template <bool SWAP>
  DI void run(const f32x4 (&acc)[4][8], int tm, int tn, int wm, int wn, int fr, int quad) const {
    static_assert(SWAP, "swapped form only");
    const Params& P = *p;
    const int n0 = tn * 128 + wn * 64, m0 = tm * 256 + wm * 128;
#pragma unroll
    for (int j = 0; j < 8; ++j) {
      const int t = m0 + 16 * j + fr;
      float ss = 0.f;
      u32x2 hb[4];
#pragma unroll
      for (int i = 0; i < 4; ++i) {
        const size_t off = (size_t)t * DM + n0 + 16 * i + quad * 4;
        const f32x4 xv = *(const f32x4*)(P.x + off);
        const f32x4 hv = xv + acc[i][j];
        *(f32x4*)(P.out + off) = hv;
        hb[i].x = pk2(hv[0], hv[1]); hb[i].y = pk2(hv[2], hv[3]);
        ss += hv[0] * hv[0] + hv[1] * hv[1] + hv[2] * hv[2] + hv[3] * hv[3];
      }
#pragma unroll
      for (int ip = 0; ip < 2; ++ip) {
        int col; const u32x4 w = pair16(hb[2 * ip], hb[2 * ip + 1], quad, ip, &col);
        *(u32x4*)(P.h1bf + (size_t)t * DM + n0 + col) = w;
      }
      ss += __shfl_xor(ss, 16); ss += __shfl_xor(ss, 32);
      if (quad == 0) P.part2[(size_t)t * 32 + tn * 2 + wn] = ss;
    }
  }
};

struct EpiPQ {
  const Params* p;
  template <bool SWAP>
  DI void run(const f32x4 (&acc)[4][8], int tm, int tn, int wm, int wn, int fr, int quad) const {
    static_assert(SWAP, "swapped form only");
    const Params& P = *p;
    const int n0 = tn * 128 + wn * 64, m0 = tm * 256 + wm * 128;
#pragma unroll
    for (int j = 0; j < 8; ++j) {
      const int t = m0 + 16 * j + fr;
#pragma unroll
      for (int ip = 0; ip < 2; ++ip) {
        u32x2 e, o; e.x = pk2(acc[2 * ip][j][0], acc[2 * ip][j][1]); e.y = pk2(acc[2 * ip][j][2], acc[2 * ip][j][3]);
        o.x = pk2(acc[2 * ip + 1][j][0], acc[2 * ip + 1][j][1]); o.y = pk2(acc[2 * ip + 1][j][2], acc[2 * ip + 1][j][3]);
        int col; const u32x4 w = pair16(e, o, quad, ip, &col);
        *(u32x4*)(P.xn + (size_t)t * DM + n0 + col) = w;
      }
    }
  }
};

struct AttnLds { u16 k[3][64 * 72]; u16 v[3][64 * 72]; float cb[3][64]; float cmax[3]; float wmin[2][4]; float wq[4]; int nv; int pad[2]; };

template <bool FOX>
DI void attn_unit(const Params& P, AttnLds* L, int b, int h, int qbase, int kbase, int dstride, int kt0, int kt1, int mlo, int mhi, int pat) {
  const int tid = threadIdx.x, lane = tid & 63, wid = tid >> 6, fr = lane & 15, quad = lane >> 4;
  const int bh = b * NH + h;
  const u16* qptr = (FOX ? P.fq : P.dq) + (size_t)bh * SEQ * 64;
  const u16* kptr = (FOX ? P.fk : P.dk) + (size_t)bh * SEQ * 64;
  const u16* vptr = FOX ? (P.fvt + (size_t)bh * 64 * SEQ) : (P.dv + (size_t)bh * SEQ * 64);
  const float* lfp = P.logf + (size_t)bh * SEQ;
  float bq = 0.f;
  bf16x8 qf[2][2];
#pragma unroll
  for (int qs = 0; qs < 2; ++qs)
#pragma unroll
    for (int ks = 0; ks < 2; ++ks) {
      const int pos = qbase + (32 * wid + 16 * qs + fr) * dstride;
      qf[qs][ks] = *(const bf16x8*)(qptr + (size_t)pos * 64 + 32 * ks + quad * 8);
    }
  float mrow[2] = {-INFINITY, -INFINITY};
  f32x4 lacc[2] = {(f32x4){0.f, 0.f, 0.f, 0.f}, (f32x4){0.f, 0.f, 0.f, 0.f}};
  const bf16x8 ones = {0x3F80, 0x3F80, 0x3F80, 0x3F80, 0x3F80, 0x3F80, 0x3F80, 0x3F80};
  f32x4 o[4][2];
#pragma unroll
  for (int dt = 0; dt < 4; ++dt) { o[dt][0] = (f32x4){0.f, 0.f, 0.f, 0.f}; o[dt][1] = (f32x4){0.f, 0.f, 0.f, 0.f}; }
  float carry = 0.f;
  const int lr = tid >> 3, lc = (tid & 7) * 8;
  u32x4 rk[2], rv[2]; float rl = 0.f;
  auto gload = [&](int kt) {
#pragma unroll
    for (int i = 0; i < 2; ++i) {
      const int key = lr + 32 * i;
      const int pos = kbase + (64 * kt + key) * dstride;
      rk[i] = *(const u32x4*)(kptr + (size_t)pos * 64 + lc);
      if (FOX) rv[i] = *(const u32x4*)(vptr + (size_t)key * SEQ + 64 * kt + lc);
      else rv[i] = *(const u32x4*)(vptr + (size_t)pos * 64 + lc);
    }
    if (FOX && wid == 0) rl = lfp[64 * kt + lane];
  };
  auto sstore = [&](int buf) {
#pragma unroll
    for (int i = 0; i < 2; ++i) {
      const int key = lr + 32 * i;
      *(u32x4*)(&L->k[buf][key * 72 + lc]) = rk[i];
      if (FOX) *(u32x4*)(&L->v[buf][key * 72 + lc]) = rv[i];
      else {
        const unsigned w[4] = {rv[i][0], rv[i][1], rv[i][2], rv[i][3]};
#pragma unroll
        for (int e = 0; e < 4; ++e) {
          L->v[buf][(lc + 2 * e) * 72 + key] = (u16)(w[e] & 0xffffu);
          L->v[buf][(lc + 2 * e + 1) * 72 + key] = (u16)(w[e] >> 16);
        }
      }
    }
    if (FOX && wid == 0) {
      float v = rl;
#pragma unroll
      for (int off = 1; off < 64; off <<= 1) { const float n = __shfl_down(v, off); if (lane + off < 64) v += n; }
      L->cb[buf][lane] = carry + v - rl;
      if (lane == 0) L->cmax[buf] = carry;
      carry += __shfl(v, 0);
    }
  };
  const int count = kt1 - kt0;
  const int start = FOX ? kt1 - 1 : kt0, step = FOX ? -1 : 1;
  __syncthreads();
  gload(start); sstore(0);
  if (count > 1) gload(start + step);
  if (FOX) {
    float n2[2] = {0.f, 0.f};
#pragma unroll
    for (int qs = 0; qs < 2; ++qs)
#pragma unroll
      for (int ks = 0; ks < 2; ++ks)
#pragma unroll
        for (int e = 0; e < 8; ++e) { const float v = __uint_as_float(((unsigned)(unsigned short)qf[qs][ks][e]) << 16); n2[qs] += v * v; }
    float q2 = 0.f;
#pragma unroll
    for (int qs = 0; qs < 2; ++qs) { float v = n2[qs]; v += __shfl_xor(v, 16); v += __shfl_xor(v, 32); q2 = fmaxf(q2, v); }
    q2 = fmaxf(q2, __shfl_xor(q2, 1)); q2 = fmaxf(q2, __shfl_xor(q2, 2)); q2 = fmaxf(q2, __shfl_xor(q2, 4)); q2 = fmaxf(q2, __shfl_xor(q2, 8));
    if (lane == 0) { L->wmin[0][wid] = -INFINITY; L->wq[wid] = q2; }
  }
  __syncthreads();
  if (FOX) {
    const float q2 = fmaxf(fmaxf(L->wq[0], L->wq[1]), fmaxf(L->wq[2], L->wq[3]));
    bq = sqrtf(q2 * P.qkmax[64 + bh]) * 1.03f + 32.0f;
  }
  int bcur = 0;
  for (int it = 0; it < count; ++it) {
    const int kt = start + it * step;
    const int cur = it & 1, bnext = bcur == 2 ? 0 : bcur + 1;
    if (FOX && it >= 2) {
      const float m4 = fminf(fminf(L->wmin[cur][0], L->wmin[cur][1]), fminf(L->wmin[cur][2], L->wmin[cur][3]));
      if (bq + L->cmax[bcur] < m4) break;
    }
    if (it + 1 < count) sstore(bnext);
    if (it + 2 < count) gload(kt + 2 * step);
    const bool need_mask = FOX ? (it < 2) : true;
    const bool wave_dead = need_mask && ((64 * kt + 63 - 32 * wid) < mlo || (64 * kt - 32 * wid - 31) > mhi);
    if (!wave_dead) {
    f32x4 st[4][2];
#pragma unroll
    for (int kk = 0; kk < 4; ++kk) { st[kk][0] = (f32x4){0.f, 0.f, 0.f, 0.f}; st[kk][1] = (f32x4){0.f, 0.f, 0.f, 0.f}; }
#pragma unroll
    for (int ks = 0; ks < 2; ++ks)
#pragma unroll
      for (int kk = 0; kk < 4; ++kk) {
        const bf16x8 kf = *(const bf16x8*)(&L->k[bcur][(16 * kk + fr) * 72 + 32 * ks + quad * 8]);
        st[kk][0] = MFMA16(kf, qf[0][ks], st[kk][0]);
        st[kk][1] = MFMA16(kf, qf[1][ks], st[kk][1]);
      }
    if (FOX) {
#pragma unroll
      for (int kk = 0; kk < 4; ++kk) {
        const f32x4 cbv = *(const f32x4*)(&L->cb[bcur][16 * kk + quad * 4]);
        st[kk][0] += cbv; st[kk][1] += cbv;
      }
    }
    if (need_mask) {
#pragma unroll
      for (int kk = 0; kk < 4; ++kk)
#pragma unroll
        for (int qs = 0; qs < 2; ++qs)
#pragma unroll
          for (int r = 0; r < 4; ++r) {
            const int dlt = (64 * kt + 16 * kk + quad * 4 + r) - (32 * wid + 16 * qs + fr);
            if (dlt < mlo || dlt > mhi) st[kk][qs][r] = -INFINITY;
          }
    }
#pragma unroll
    for (int qs = 0; qs < 2; ++qs) {
      float tmax = -INFINITY;
#pragma unroll
      for (int kk = 0; kk < 4; ++kk)
#pragma unroll
        for (int r = 0; r < 4; ++r) tmax = fmaxf(tmax, st[kk][qs][r]);
      tmax = fmaxf(tmax, __shfl_xor(tmax, 16)); tmax = fmaxf(tmax, __shfl_xor(tmax, 32));
      const float mold = mrow[qs];
      const float mn = fmaxf(mold, tmax);
      const float mu = (mn == -INFINITY) ? 0.f : mn;
      mrow[qs] = mn;
      if (__builtin_amdgcn_ballot_w64(mn > mold) != 0ull) {
        const float alpha = __builtin_amdgcn_exp2f(mold - mu);
        lacc[qs] *= alpha;
#pragma unroll
        for (int dt = 0; dt < 4; ++dt) o[dt][qs] *= alpha;
      }
#pragma unroll
      for (int kk = 0; kk < 4; ++kk)
#pragma unroll
        for (int r = 0; r < 4; ++r) st[kk][qs][r] = __builtin_amdgcn_exp2f(st[kk][qs][r] - mu);
    }
#pragma unroll
    for (int ks2 = 0; ks2 < 2; ++ks2) {
      bf16x8 pf[2];
#pragma unroll
      for (int qs = 0; qs < 2; ++qs) {
        u32x4 w;
        w.x = pk2(st[2 * ks2][qs][0], st[2 * ks2][qs][1]); w.y = pk2(st[2 * ks2][qs][2], st[2 * ks2][qs][3]);
        w.z = pk2(st[2 * ks2 + 1][qs][0], st[2 * ks2 + 1][qs][1]); w.w = pk2(st[2 * ks2 + 1][qs][2], st[2 * ks2 + 1][qs][3]);
        pf[qs] = __builtin_bit_cast(bf16x8, w);
      }
      lacc[0] = MFMA16(ones, pf[0], lacc[0]);
      lacc[1] = MFMA16(ones, pf[1], lacc[1]);
#pragma unroll
      for (int dt = 0; dt < 4; ++dt) {
        const s16x4 lo = *(const s16x4*)(&L->v[bcur][(16 * dt + fr) * 72 + 32 * ks2 + quad * 4]);
        const s16x4 hi = *(const s16x4*)(&L->v[bcur][(16 * dt + fr) * 72 + 32 * ks2 + 16 + quad * 4]);
        const bf16x8 vf = __builtin_shufflevector(lo, hi, 0, 1, 2, 3, 4, 5, 6, 7);
        o[dt][0] = MFMA16(vf, pf[0], o[dt][0]);
        o[dt][1] = MFMA16(vf, pf[1], o[dt][1]);
      }
    }
    }
    if (FOX) {
      float mm = fminf(mrow[0], mrow[1]);
      mm = fminf(mm, __shfl_xor(mm, 1)); mm = fminf(mm, __shfl_xor(mm, 2)); mm = fminf(mm, __shfl_xor(mm, 4)); mm = fminf(mm, __shfl_xor(mm, 8));
      if (lane == 0) L->wmin[cur ^ 1][wid] = mm;
    }
    __syncthreads();
    bcur = bnext;
  }
#pragma unroll
  for (int qs = 0; qs < 2; ++qs) {
    const float lt = lacc[qs][0];
    const float inv = 1.0f / lt;
    const int pos = qbase + (32 * wid + 16 * qs + fr) * dstride;
    const size_t t = (size_t)b * SEQ + pos;
    u16* orow = FOX ? (P.foxo + t * 1024 + h * 64) : (P.dilop + ((size_t)pat * T + t) * 1024 + h * 64);
#pragma unroll
    for (int ip = 0; ip < 2; ++ip) {
      const f32x4 v0 = o[2 * ip][qs] * inv, v1 = o[2 * ip + 1][qs] * inv;
      u32x2 e, od; e.x = pk2(v0[0], v0[1]); e.y = pk2(v0[2], v0[3]); od.x = pk2(v1[0], v1[1]); od.y = pk2(v1[2], v1[3]);
      int col; const u32x4 w = pair16(e, od, quad, ip, &col);
      *(u32x4*)(orow + col) = w;
    }
    if (!FOX && quad == 0) P.lse[((size_t)pat * T + t) * NH + h] = mrow[qs] + __builtin_amdgcn_logf(lt);
  }
}

DI void phase_attn(const Params& P, char* lds) {
  AttnLds* L = (AttnLds*)lds;
  const int xcd = blockIdx.x & 7;
  int nxt = 0;
  if (threadIdx.x == 0) nxt = atomicAdd(P.ctr + xcd, 1);
  for (;;) {
    if (threadIdx.x == 0) L->nv = nxt;
    __syncthreads();
    const int v = L->nv;
    if (v >= 2048) break;
    if (threadIdx.x == 0) nxt = atomicAdd(P.ctr + xcd, 1);
    if (v < 512) {
      const int qb = 63 - (v >> 3), bh = xcd * 8 + (v & 7);
      attn_unit<true>(P, L, bh >> 4, bh & 15, 128 * qb, 0, 1, 0, 2 * (qb + 1), -(1 << 28), 128 * qb, 0);
    } else {
      const int v2 = v - 512, bh = xcd * 8 + (v2 & 7), w = v2 >> 3, pat = w >> 6, rn = w & 63;
      int d, r, n;
      if (pat == 0) { d = 1; r = 0; n = rn; } else if (pat == 1) { d = 4; r = rn >> 4; n = rn & 15; } else { d = 16; r = rn >> 2; n = rn & 3; }
      attn_unit<false>(P, L, bh >> 4, bh & 15, r + d * 128 * n, r + d * 128 * (n - 1), d, n == 0 ? 2 : 0, 4, 0, 128, pat);
    }
  }
}

DI void phase_mix(const Params& P) {
  const int tid = threadIdx.x, lane = tid & 63, wid = tid >> 6;
  const int gw = blockIdx.x * 4 + wid, nw = gridDim.x * 4;
  u16* mixed = P.xn;
  for (int t = gw; t < T; t += nw) {
    const int c0 = lane * 16;
    {
      const uint4* src = (const uint4*)(P.foxo + (size_t)t * 1024 + c0);
      const uint4 a = src[0], b2 = src[1];
      const unsigned w[8] = {a.x, a.y, a.z, a.w, b2.x, b2.y, b2.z, b2.w};
      float v[16]; float ss = 0.f;
#pragma unroll
      for (int e = 0; e < 8; ++e) { v[2 * e] = bflo(w[e]); v[2 * e + 1] = bfhi(w[e]); ss += v[2 * e] * v[2 * e] + v[2 * e + 1] * v[2 * e + 1]; }
      ss = wave_sum(ss);
      const float rs = rsqrtf(ss * (1.0f / 1024.0f) + EPS);
      unsigned ow[8];
#pragma unroll
      for (int e = 0; e < 8; ++e) ow[e] = pk2(v[2 * e] * rs * P.fox_gain[c0 + 2 * e], v[2 * e + 1] * rs * P.fox_gain[c0 + 2 * e + 1]);
      uint4* dst = (uint4*)(mixed + (size_t)t * DM + c0);
      dst[0] = make_uint4(ow[0], ow[1], ow[2], ow[3]); dst[1] = make_uint4(ow[4], ow[5], ow[6], ow[7]);
    }
    {
      const int head = lane >> 2;
      float l0 = P.lse[((size_t)0 * T + t) * NH + head], l1 = P.lse[((size_t)1 * T + t) * NH + head], l2 = P.lse[((size_t)2 * T + t) * NH + head];
      const float mx = fmaxf(l0, fmaxf(l1, l2));
      float w0 = __builtin_amdgcn_exp2f(l0 - mx), w1 = __builtin_amdgcn_exp2f(l1 - mx), w2 = __builtin_amdgcn_exp2f(l2 - mx);
      const float inv = 1.0f / (w0 + w1 + w2); w0 *= inv; w1 *= inv; w2 *= inv;
      const float wp[3] = {w0, w1, w2};
      float v[16];
#pragma unroll
      for (int e = 0; e < 16; ++e) v[e] = 0.f;
#pragma unroll
      for (int pp = 0; pp < 3; ++pp) {
        const uint4* src = (const uint4*)(P.dilop + ((size_t)pp * T + t) * 1024 + c0);
        const uint4 a = src[0], b2 = src[1];
        const unsigned w[8] = {a.x, a.y, a.z, a.w, b2.x, b2.y, b2.z, b2.w};
#pragma unroll
        for (int e = 0; e < 8; ++e) { v[2 * e] += wp[pp] * bflo(w[e]); v[2 * e + 1] += wp[pp] * bfhi(w[e]); }
      }
      float ss = 0.f;
#pragma unroll
      for (int e = 0; e < 16; ++e) ss += v[e] * v[e];
      ss = wave_sum(ss);
      const float rs = rsqrtf(ss * (1.0f / 1024.0f) + EPS);
      unsigned ow[8];
#pragma unroll
      for (int e = 0; e < 8; ++e) ow[e] = pk2(v[2 * e] * rs * P.dil_gain[c0 + 2 * e], v[2 * e + 1] * rs * P.dil_gain[c0 + 2 * e + 1]);
      uint4* dst = (uint4*)(mixed + (size_t)t * DM + 1024 + c0);
      dst[0] = make_uint4(ow[0], ow[1], ow[2], ow[3]); dst[1] = make_uint4(ow[4], ow[5], ow[6], ow[7]);
    }
  }
}

struct TopkLds { int ix[16 * 32]; };

DI unsigned f2key(float f) { const unsigned u = __float_as_uint(f); return u ^ ((unsigned)((int)u >> 31) | 0x80000000u); }
DI float key2f(unsigned k) { const unsigned u = (k & 0x80000000u) ? (k ^ 0x80000000u) : ~k; return __uint_as_float(u); }
DI unsigned umax(unsigned a, unsigned b) { return a > b ? a : b; }
DI unsigned umin(unsigned a, unsigned b) { return a < b ? a : b; }

DI void sort16_desc(unsigned (&k)[16]) {
#pragma unroll
  for (int size = 2; size <= 16; size <<= 1)
#pragma unroll
    for (int stride = size >> 1; stride > 0; stride >>= 1)
#pragma unroll
      for (int i = 0; i < 16; ++i) {
        const int l = i ^ stride;
        if (l > i) {
          const bool desc = ((i & size) == 0);
          const unsigned a = k[i], b = k[l];
          const unsigned mx = umax(a, b), mn = umin(a, b);
          k[i] = desc ? mx : mn; k[l] = desc ? mn : mx;
        }
      }
}
DI void merge_top16(unsigned (&a)[16], const unsigned (&b)[16]) {
#pragma unroll
  for (int i = 0; i < 16; ++i) a[i] = umax(a[i], b[15 - i]);
#pragma unroll
  for (int stride = 8; stride > 0; stride >>= 1)
#pragma unroll
    for (int i = 0; i < 16; ++i) {
      const int l = i ^ stride;
      if (l > i) { const unsigned x = a[i], y = a[l]; a[i] = umax(x, y); a[l] = umin(x, y); }
    }
}
DI void xquad_top16(unsigned (&a)[16]) {
#pragma unroll
  for (int off = 16; off <= 32; off <<= 1) {
    unsigned b[16];
#pragma unroll
    for (int i = 0; i < 16; ++i) b[i] = (unsigned)__shfl_xor((int)a[i], off);
    merge_top16(a, b);
  }
}
constexpr int cand_ci(int c) { int n = 0; for (int ci = 0; ci < 16; ++ci) for (int cj = 0; cj < 16; ++cj) if ((ci + 1) * (cj + 1) <= 16) { if (n == c) return ci; ++n; } return 0; }
constexpr int cand_cj(int c) { int n = 0; for (int ci = 0; ci < 16; ++ci) for (int cj = 0; cj < 16; ++cj) if ((ci + 1) * (cj + 1) <= 16) { if (n == c) return cj; ++n; } return 0; }

DI void phase_topk(const Params& P, char* lds) {
  const int tid = threadIdx.x, lane = tid & 63, wid = tid >> 6, fr = lane & 15, quad = lane >> 4;
  const int h = blockIdx.x & 7;
  u16* kl = (u16*)lds;
  for (int idx = tid; idx < 4096; idx += 256) {
    const int row = idx >> 4, c = idx & 15;
    const u32x4 v = *(const u32x4*)(P.keysb + ((size_t)h * 256 + row) * 128 + c * 8);
    *(u32x4*)(kl + row * 128 + ((c ^ (row & 15)) * 8)) = v;
  }
  __syncthreads();
  TopkLds* L = (TopkLds*)(lds + 65536 + wid * sizeof(TopkLds));
  const u16* qp = P.xn;
  const int gstep = (gridDim.x >> 3) * 4;
  for (int g = (blockIdx.x >> 3) * 4 + wid; g < T / 16; g += gstep) {
    const int t0 = g * 16;
    float rs;
    {
      const f32x4* pp = (const f32x4*)(P.part2 + (size_t)(t0 + fr) * 32);
      float ss = 0.f;
#pragma unroll
      for (int i = 0; i < 8; ++i) { const f32x4 v = pp[i]; ss += (v[0] + v[1]) + (v[2] + v[3]); }
      rs = rsqrtf(ss * (1.0f / DM) + EPS);
    }
    float av[2][16];
#pragma unroll
    for (int pp = 0; pp < 2; ++pp) {
      bf16x8 qf[4];
#pragma unroll
      for (int ks = 0; ks < 4; ++ks) qf[ks] = *(const bf16x8*)(qp + (size_t)(t0 + fr) * DM + h * 256 + pp * 128 + ks * 32 + quad * 8);
      unsigned klo[16], khi[16];
#pragma unroll
      for (int nt = 0; nt < 8; ++nt) {
        f32x4 acc = {0.f, 0.f, 0.f, 0.f};
#pragma unroll
        for (int ks = 0; ks < 4; ++ks) {
          const bf16x8 kf = *(const bf16x8*)(kl + (pp * 128 + nt * 16 + fr) * 128 + (((ks * 4 + quad) ^ fr) * 8));
          acc = MFMA16(kf, qf[ks], acc);
        }
#pragma unroll
        for (int r = 0; r < 4; ++r) {
          const unsigned key = (f2key(acc[r] * rs) & ~127u) | (unsigned)(127 - (16 * nt + quad * 4 + r));
          if (nt < 4) klo[nt * 4 + r] = key; else khi[(nt - 4) * 4 + r] = key;
        }
      }
      sort16_desc(klo); sort16_desc(khi);
      merge_top16(klo, khi);
      xquad_top16(klo);
#pragma unroll
      for (int i = 0; i < 16; ++i) av[pp][i] = key2f(klo[i] & ~127u);
      if (quad == 0) {
#pragma unroll
        for (int i = 0; i < 16; i += 4)
          *(int4*)(&L->ix[fr * 32 + pp * 16 + i]) = make_int4(127 - (int)(klo[i] & 127u), 127 - (int)(klo[i + 1] & 127u), 127 - (int)(klo[i + 2] & 127u), 127 - (int)(klo[i + 3] & 127u));
      }
    }
    unsigned ck[16];
#pragma unroll
    for (int s = 0; s < 16; ++s) {
      if (s < 13) {
        float v[4]; unsigned code[4];
#pragma unroll
        for (int q = 0; q < 4; ++q) {
          const int c = 4 * s + q;
          if (c < 50) { v[q] = av[0][cand_ci(c)] + av[1][cand_cj(c)]; code[q] = 255u - (unsigned)(cand_ci(c) * 16 + cand_cj(c)); }
          else { v[q] = -INFINITY; code[q] = 0u; }
        }
        const float vs = quad == 0 ? v[0] : (quad == 1 ? v[1] : (quad == 2 ? v[2] : v[3]));
        const unsigned cs = quad == 0 ? code[0] : (quad == 1 ? code[1] : (quad == 2 ? code[2] : code[3]));
        ck[s] = (f2key(vs) & ~255u) | cs;
        if (4 * s + 3 >= 50) { if (4 * s + quad >= 50) ck[s] = 0u; }
      } else ck[s] = 0u;
    }
    sort16_desc(ck);
    xquad_top16(ck);
    asm volatile("s_waitcnt lgkmcnt(0)" ::: "memory");
    float gv[16]; int ev[16];
    float sum = 0.f;
    const float mx0 = key2f(ck[0] & ~255u);
#pragma unroll
    for (int k = 0; k < 16; ++k) {
      gv[k] = expf(key2f(ck[k] & ~255u) - mx0); sum += gv[k];
      const int flat = 255 - (int)(ck[k] & 255u);
      ev[k] = L->ix[fr * 32 + (flat >> 4)] * 128 + L->ix[fr * 32 + 16 + (flat & 15)];
    }
    const float inv = 1.0f / sum;
    if (quad == 0) {
      const size_t ob = (size_t)(t0 + fr) * 128 + h * 16;
#pragma unroll
      for (int k = 0; k < 16; k += 4) {
        *(int4*)(P.experts + ob + k) = make_int4(ev[k], ev[k + 1], ev[k + 2], ev[k + 3]);
        *(float4*)(P.gates + ob + k) = make_float4(gv[k] * inv, gv[k + 1] * inv, gv[k + 2] * inv, gv[k + 3] * inv);
      }
    }
    asm volatile("s_waitcnt lgkmcnt(0)" ::: "memory");
  }
}

DI float gelu_tanh(float x) { return 0.5f * x * (1.0f + tanhf(0.7978845608028654f * (x + 0.044715f * x * x * x))); }

DI f32x32 load_row_fp6(const unsigned char* tab, int e, int lane) {
  const u32x2* rp = (const u32x2*)(tab + (size_t)e * ROWB + lane * 24);
  const u32x2 a = rp[0], b = rp[1], c = rp[2];
  const u32x6 w = {a[0], a[1], b[0], b[1], c[0], c[1]};
  return __builtin_amdgcn_cvt_scalef32_pk32_f32_fp6(w, 1.0f);
}

DI void phase_peer(const Params& P, char* lds) {
  const int tid = threadIdx.x, lane = tid & 63, wid = tid >> 6;
  f32x4* stash = (f32x4*)(lds + wid * 8192);
  const int gw = blockIdx.x * 4 + wid, nw = gridDim.x * 4;
  for (int t = gw; t < T; t += nw) {
    int lo4 = lane * 4; asm volatile("" : "+v"(lo4));
    float hn[32];
    {
      float hv[32]; float ss = 0.f;
#pragma unroll
      for (int j = 0; j < 8; ++j) {
        const f32x4 a = *(const f32x4*)(P.out + (size_t)t * DM + 256 * j + 4 * lane);
        stash[j * 64 + lane] = a;
        hv[4 * j + 0] = a[0]; hv[4 * j + 1] = a[1]; hv[4 * j + 2] = a[2]; hv[4 * j + 3] = a[3];
      }
#pragma unroll
      for (int e = 0; e < 32; ++e) ss += hv[e] * hv[e];
      ss = wave_sum(ss);
      const float rs = rsqrtf(ss * (1.0f / DM) + EPS);
#pragma unroll
      for (int j = 0; j < 8; ++j) {
        const f32x4 g = *(const f32x4*)(P.ffn_gain + 256 * j + lo4);
#pragma unroll
        for (int q = 0; q < 4; ++q) hn[4 * j + q] = hv[4 * j + q] * rs * g[q];
      }
    }
    const int e_lo = P.experts[(size_t)t * 128 + lane], e_hi = P.experts[(size_t)t * 128 + 64 + lane];
    const float g_lo = P.gates[(size_t)t * 128 + lane], g_hi = P.gates[(size_t)t * 128 + 64 + lane];
    const float ds_lo = P.dscale[e_lo], ds_hi = P.dscale[e_hi], us_lo = P.uscale[e_lo], us_hi = P.uscale[e_hi];
    float w_lo = 0.f, w_hi = 0.f;
    {
      float wl = 0.f, wh = 0.f;
      u32x2 b0[4][3], b1[4][3];
      auto issueA = [&](u32x2 (&buf)[4][3], int bi) {
        const int ev = (bi & 16) ? e_hi : e_lo;
#pragma unroll
        for (int u = 0; u < 4; ++u) {
          const int e = __builtin_amdgcn_readlane(ev, (bi & 15) * 4 + u);
          const u32x2* rp = (const u32x2*)(P.down8 + (size_t)e * ROWB + lane * 24);
          buf[u][0] = rp[0]; buf[u][1] = rp[1]; buf[u][2] = rp[2];
        }
      };
      auto consumeA = [&](const u32x2 (&buf)[4][3], int bi) {
#pragma unroll
        for (int u = 0; u < 4; ++u) {
          const u32x6 w = {buf[u][0][0], buf[u][0][1], buf[u][1][0], buf[u][1][1], buf[u][2][0], buf[u][2][1]};
          const f32x32 f = __builtin_amdgcn_cvt_scalef32_pk32_f32_fp6(w, 1.0f);
          float d = 0.f;
#pragma unroll
          for (int i = 0; i < 32; ++i) d += f[i] * hn[i];
          d = wave_sum(d);
          const bool mine = lane == (bi & 15) * 4 + u;
          if (mine && !(bi & 16)) wl = d;
          if (mine && (bi & 16)) wh = d;
          __builtin_amdgcn_sched_barrier(0);
        }
      };
      issueA(b0, 0);
      __builtin_amdgcn_sched_barrier(0);
#pragma unroll 1
      for (int bi = 0; bi < 32; bi += 2) {
        issueA(b1, bi + 1);
        __builtin_amdgcn_sched_barrier(0);
        consumeA(b0, bi);
        if (bi + 2 < 32) issueA(b0, bi + 2);
        __builtin_amdgcn_sched_barrier(0);
        consumeA(b1, bi + 1);
      }
      w_lo = g_lo * gelu_tanh(wl * ds_lo) * us_lo;
      w_hi = g_hi * gelu_tanh(wh * ds_hi) * us_hi;
    }
    float y[32];
#pragma unroll
    for (int e = 0; e < 32; ++e) y[e] = 0.f;
    {
      u32x2 b0[4][3], b1[4][3];
      auto issueB = [&](u32x2 (&buf)[4][3], int bi) {
        const int ev = (bi & 16) ? e_hi : e_lo;
#pragma unroll
        for (int u = 0; u < 4; ++u) {
          const int e = __builtin_amdgcn_readlane(ev, (bi & 15) * 4 + u);
          const u32x2* rp = (const u32x2*)(P.up8 + (size_t)e * ROWB + lane * 24);
          buf[u][0] = rp[0]; buf[u][1] = rp[1]; buf[u][2] = rp[2];
        }
      };
      auto consumeB = [&](const u32x2 (&buf)[4][3], int bi) {
        const float wv = (bi & 16) ? w_hi : w_lo;
#pragma unroll
        for (int u = 0; u < 4; ++u) {
          const float ws = __int_as_float(__builtin_amdgcn_readlane(__float_as_int(wv), (bi & 15) * 4 + u));
          const u32x6 w = {buf[u][0][0], buf[u][0][1], buf[u][1][0], buf[u][1][1], buf[u][2][0], buf[u][2][1]};
          const f32x32 f = __builtin_amdgcn_cvt_scalef32_pk32_f32_fp6(w, 1.0f);
#pragma unroll
          for (int i = 0; i < 32; ++i) y[i] += ws * f[i];
          __builtin_amdgcn_sched_barrier(0);
        }
      };
      issueB(b0, 0);
      __builtin_amdgcn_sched_barrier(0);
#pragma unroll 1
      for (int bi = 0; bi < 32; bi += 2) {
        issueB(b1, bi + 1);
        __builtin_amdgcn_sched_barrier(0);
        consumeB(b0, bi);
        if (bi + 2 < 32) issueB(b0, bi + 2);
        __builtin_amdgcn_sched_barrier(0);
        consumeB(b1, bi + 1);
      }
    }
    float s2 = 0.f;
    float* hp2 = P.out + (size_t)t * DM + 4 * lane; asm volatile("" : "+v"(hp2));
#pragma unroll
    for (int j = 0; j < 8; ++j) {
      const f32x4 a = stash[j * 64 + lane];
#pragma unroll
      for (int q = 0; q < 4; ++q) y[4 * j + q] += a[q];
    }
#pragma unroll
    for (int e = 0; e < 32; ++e) s2 += y[e] * y[e];
    s2 = wave_sum(s2);
    const float r2 = rsqrtf(s2 * (1.0f / DM) + EPS);
    int lo4b = lane * 4; asm volatile("" : "+v"(lo4b));
#pragma unroll
    for (int j = 0; j < 8; ++j) {
      const f32x4 g = *(const f32x4*)(P.final_gain + 256 * j + lo4b);
      f32x4 o;
#pragma unroll
      for (int q = 0; q < 4; ++q) o[q] = y[4 * j + q] * r2 * g[q];
      *(f32x4*)(hp2 + 256 * j) = o;
    }
  }
}


#define XB_TMO      128
#define XB_XCNT(j)  (256  + 64 * (j))
#define XB_XSUB(j)  (1280 + 64 * (j))
#define XB_XGEN(j)  (2304 + 64 * (j))
#define XB_TOP      3328
#define XB_TOPGEN   3392
#define XCD_BAR_WORDS 3456
#define XB_SPIN_CAP (1u << 22)

__device__ __forceinline__ unsigned xb_ld(unsigned* p)              { return __hip_atomic_load(p, __ATOMIC_RELAXED, __HIP_MEMORY_SCOPE_AGENT); }
__device__ __forceinline__ unsigned xb_add(unsigned* p, unsigned v) { return __hip_atomic_fetch_add(p, v, __ATOMIC_RELAXED, __HIP_MEMORY_SCOPE_AGENT); }
__device__ __forceinline__ unsigned xb_xcc_id() { return (unsigned)__builtin_amdgcn_s_getreg((3 << 11) | 20) & 0xFu; }
#define XB_SPIN(cond, bar) do { unsigned _sp = 0; while (cond) { __builtin_amdgcn_s_sleep(1); \
    if ((++_sp & 255u) == 0u) { if (xb_ld(&(bar)[XB_TMO])) break; if (_sp > XB_SPIN_CAP) { atomicAdd(&(bar)[XB_TMO], 1u); break; } } } } while (0)

struct XcdBarrier {
    unsigned* bar; unsigned x;
    volatile LAS unsigned* st;
};

__device__ __forceinline__ XcdBarrier xcd_barrier_post(unsigned* bar, volatile LAS unsigned* st) {
    XcdBarrier b; b.bar = bar; b.x = xb_xcc_id(); b.st = st;
    if (threadIdx.x == 0) (void)xb_add(&bar[XB_XCNT(b.x)], 1u);
    return b;
}
__device__ __forceinline__ void xcd_barrier_complete(unsigned* bar, unsigned x, unsigned& nloc, unsigned& nx) {
    const unsigned G = gridDim.x * gridDim.y * gridDim.z;
    unsigned sum, cnt, mine, sp = 0u;
    for (;;) {
        sum = 0u; cnt = 0u; mine = 0u;
#pragma unroll
        for (unsigned j = 0; j < 16; ++j) { const unsigned c = xb_ld(&bar[XB_XCNT(j)]); sum += c; cnt += (c > 0u) ? 1u : 0u; mine = (j == x) ? c : mine; }
        if (sum == G) break;
        __builtin_amdgcn_s_sleep(1);
        if ((++sp & 255u) == 0u) { if (xb_ld(&bar[XB_TMO])) break; if (sp > XB_SPIN_CAP) { atomicAdd(&bar[XB_TMO], 1u); break; } }
    }
    nloc = mine > 0u ? mine : 1u; nx = cnt > 0u ? cnt : 1u;
}

__device__ __forceinline__ void xcd_barrier(const XcdBarrier& b) {
    asm volatile("s_waitcnt vmcnt(0)" ::: "memory");
    __syncthreads();
    if (threadIdx.x == 0) {
        unsigned* bar = b.bar;
        __builtin_amdgcn_s_waitcnt(0);
        unsigned nloc = b.st[0], nx = b.st[1];
        if (nloc == 0u) { xcd_barrier_complete(bar, b.x, nloc, nx); b.st[0] = nloc; b.st[1] = nx; }
        const unsigned old = xb_add(&bar[XB_XSUB(b.x)], 1u);
        const unsigned gen = old / nloc;
        if (old + 1u == (gen + 1u) * nloc) {
            __builtin_amdgcn_fence(__ATOMIC_RELEASE, "agent");
            asm volatile("s_waitcnt vmcnt(0)" ::: "memory");
            const unsigned og = xb_add(&bar[XB_TOP], 1u);
            const unsigned tg = og / nx;
            if (og + 1u == (tg + 1u) * nx) xb_add(&bar[XB_TOPGEN], 1u);
            else XB_SPIN(xb_ld(&bar[XB_TOPGEN]) == tg, bar);
            __builtin_amdgcn_fence(__ATOMIC_ACQUIRE, "agent");
            xb_add(&bar[XB_XGEN(b.x)], 1u);
            asm volatile("s_waitcnt vmcnt(0)" ::: "memory");
        } else {
            XB_SPIN(xb_ld(&bar[XB_XGEN(b.x)]) == gen, bar);
            __builtin_amdgcn_fence(__ATOMIC_ACQUIRE, "agent");
            asm volatile("s_waitcnt vmcnt(0)" ::: "memory");
        }
    }
    __syncthreads();
}


__global__ void __launch_bounds__(256, 2) mega(Params P) {
  __shared__ __attribute__((aligned(16))) char lds[LDS_BYTES];
  cg::grid_group grid = cg::this_grid();
  const int xcd = blockIdx.x & 7, l = blockIdx.x >> 3, Lx = gridDim.x >> 3;
  u16* sa = (u16*)lds; u16* sb = sa + 2 * 256 * 32;

  if (P.out == nullptr) grid.sync();
  __shared__ uint4 xb_words;
  if (threadIdx.x == 0) xb_words = make_uint4(0u, 0u, 0u, 0u);
  __syncthreads();
  const XcdBarrier xb = xcd_barrier_post(P.xbar, (volatile LAS unsigned*)&xb_words);
  phase_prep(P, lds);
  xcd_barrier(xb);
  {
    EpiQKV epi{&P};
    for (int i = l; i < 784; i += Lx) {
      int tm, tn;
      if (i < 768) { tm = i / 6; tn = xcd * 6 + i % 6; } else { tm = xcd + 8 * (i - 768); tn = 48; }
      const int grp = (tn * 128) >> 10;
      if (grp == 2) gemm_tile<false>(P.xn, P.winT, tm, tn, sa, sb, epi); else gemm_tile<true>(P.xn, P.winT, tm, tn, sa, sb, epi);
    }
  }
  xcd_barrier(xb);
  phase_attn(P, lds);
  xcd_barrier(xb);
  phase_mix(P);
  xcd_barrier(xb);
  {
    EpiOut epi{&P};
    for (int i = l; i < 256; i += Lx) gemm_tile<true>(P.xn, P.woutT, i >> 1, xcd * 2 + (i & 1), sa, sb, epi);
  }
  xcd_barrier(xb);
  {
    EpiPQ epi{&P};
    for (int i = l; i < 256; i += Lx) gemm_tile<true>(P.h1bf, P.wqT, i >> 1, xcd * 2 + (i & 1), sa, sb, epi);
  }
  xcd_barrier(xb);
  phase_topk(P, lds);
  xcd_barrier(xb);
  phase_peer(P, lds);
}

extern "C" void kernel_launch(void* const* d_in, const int* in_sizes, int n_in, void* d_out, int out_size, void* d_ws, size_t ws_size, hipStream_t stream) {
  static int grid_blocks = 0;
  if (!grid_blocks) {
    int dev = 0, cus = 0, per_cu = 0;
    hipGetDevice(&dev);
    hipDeviceGetAttribute(&cus, hipDeviceAttributeMultiprocessorCount, dev);
    hipOccupancyMaxActiveBlocksPerMultiprocessor(&per_cu, mega, 256, 0);
    if (per_cu > 2) per_cu = 2;
    if (per_cu < 1) per_cu = 1;
    grid_blocks = cus * per_cu;
    grid_blocks &= ~7;
  }
  Params p{};
  p.x = (const float*)d_in[0]; p.attn_gain = (const float*)d_in[1]; p.w_in = (const float*)d_in[2]; p.forget_bias = (const float*)d_in[3];
  p.fox_gain = (const float*)d_in[4]; p.dil_gain = (const float*)d_in[5]; p.w_out = (const float*)d_in[6]; p.ffn_gain = (const float*)d_in[7];
  p.peer_query = (const float*)d_in[8]; p.sub_keys = (const float*)d_in[9]; p.peer_down = (const float*)d_in[10]; p.peer_up = (const float*)d_in[11];
  p.final_gain = (const float*)d_in[12];
  p.out = (float*)d_out;
  char* w = (char*)d_ws;
  size_t off = 0;
  auto take = [&](size_t bytes) { char* r = w + off; off += (bytes + 255) & ~(size_t)255; return r; };
  const size_t MB = 1024 * 1024;
  p.xn = (u16*)take(128 * MB);
  p.fq = (u16*)take(64 * MB); p.fk = (u16*)take(64 * MB); p.fvt = (u16*)take(64 * MB);
  p.dq = (u16*)take(64 * MB); p.dk = (u16*)take(64 * MB); p.dv = (u16*)take(64 * MB);
  p.h1bf = p.fq;
  p.experts = (int*)p.dq; p.gates = (float*)p.dk;
  p.foxo = (u16*)take(64 * MB); p.dilop = (u16*)take(192 * MB); p.lse = (float*)take(6 * MB);
  p.winT = (u16*)take((size_t)6272 * 2048 * 2); p.woutT = (u16*)take(8 * MB); p.wqT = (u16*)take(8 * MB);
  p.keysb = (u16*)take(512 * 1024); p.down8 = (unsigned char*)take(32 * MB); p.up8 = (unsigned char*)take(32 * MB);
  p.dscale = (float*)take(NEXP * 4); p.uscale = (float*)take(NEXP * 4);
  p.rope = (float*)take(SEQ * 8 * 2 * 4);
  p.logf = (float*)take(2 * MB); p.part2 = (float*)take(4 * MB);
  p.qkmax = (float*)take(128 * 4); p.ctr = (int*)take(8 * 4); p.xbar = (unsigned*)take(3456 * 4);
  for (int i = 0; i < 8; ++i) p.inv_freq[i] = (float)pow(500000.0, -(double)i / 8.0);
  if (off > ws_size) { fprintf(stderr, "workspace too small: need %zu have %zu\n", off, ws_size); return; }
  hipMemsetAsync(p.xbar, 0, 3456 * 4, stream);
  void* args[] = {&p};
  hipError_t e = hipLaunchCooperativeKernel((void*)mega, dim3(grid_blocks), dim3(256), args, 0, stream);
  if (e != hipSuccess) fprintf(stderr, "cooperative launch failed: %s (grid %d)\n", hipGetErrorString(e), grid_blocks);
}
```

```cpp
#include <hip/hip_runtime.h>
#include <hip/hip_cooperative_groups.h>
#include <cstdio>
#include <cstdint>
#include <cmath>
namespace cg = cooperative_groups;

#define DI __device__ __forceinline__
typedef unsigned short u16;
typedef short bf16x8 __attribute__((ext_vector_type(8)));
typedef short s16x4 __attribute__((ext_vector_type(4)));
typedef float f32x4 __attribute__((ext_vector_type(4)));
typedef float f32x2 __attribute__((ext_vector_type(2)));
typedef unsigned u32x4 __attribute__((ext_vector_type(4)));
typedef unsigned u32x2 __attribute__((ext_vector_type(2)));
typedef __bf16 bf16v2 __attribute__((ext_vector_type(2)));

constexpr int DM = 2048, NB = 4, SEQ = 8192, T = NB * SEQ, NH = 16;
constexpr int NEXP = 16384;
constexpr float LOG2E = 1.4426950408889634f;
constexpr float EPS = 1e-6f;
constexpr int LDS_BYTES = 73728;

struct Params {
  const float *x, *attn_gain, *w_in, *forget_bias, *fox_gain, *dil_gain, *w_out, *ffn_gain, *peer_query, *sub_keys, *peer_down, *peer_up, *final_gain;
  float* out;
  u16 *xn, *winT, *woutT, *wqT, *keysb;
  unsigned char *down8, *up8;
  float *dscale, *uscale;
  float* rope;
  u16 *fq, *fk, *fvt, *dq, *dk, *dv;
  float* logf;
  u16 *foxo, *dilop;
  float* lse;
  u16* h1bf;
  float* part2;
  int* experts;
  float* gates;
  float* qkmax;
  int* ctr;
  unsigned* xbar;
  float inv_freq[8];
};

DI unsigned pk2(float a, float b) { f32x2 v = {a, b}; bf16v2 r = __builtin_convertvector(v, bf16v2); return __builtin_bit_cast(unsigned, r); }
DI float bflo(unsigned u) { return __uint_as_float(u << 16); }
DI float bfhi(unsigned u) { return __uint_as_float(u & 0xffff0000u); }
DI float wave_sum(float v) {
  v += __shfl_xor(v, 32); v += __shfl_xor(v, 16); v += __shfl_xor(v, 8); v += __shfl_xor(v, 4); v += __shfl_xor(v, 2); v += __shfl_xor(v, 1); return v;
}
#define MFMA16(a, b, c) __builtin_amdgcn_mfma_f32_16x16x32_bf16((a), (b), (c), 0, 0, 0)

DI void sincos_acc(float a, float& s, float& c) {
  const double x = (double)a;
  const double n = rint(x * 0.63661977236758134308);
  const double r = x - n * 1.57079632679489661923;
  const int q = ((int)n) & 3;
  const double r2 = r * r;
  const double sn = r * (1.0 + r2 * (-1.0 / 6.0 + r2 * (1.0 / 120.0 + r2 * (-1.0 / 5040.0 + r2 * (1.0 / 362880.0 + r2 * (-1.0 / 39916800.0))))));
  const double cs = 1.0 + r2 * (-0.5 + r2 * (1.0 / 24.0 + r2 * (-1.0 / 720.0 + r2 * (1.0 / 40320.0 + r2 * (-1.0 / 3628800.0 + r2 * (1.0 / 479001600.0))))));
  double so, co;
  if (q == 0) { so = sn; co = cs; } else if (q == 1) { so = cs; co = -sn; } else if (q == 2) { so = -sn; co = -cs; } else { so = -cs; co = sn; }
  s = (float)so; c = (float)co;
}

template <int MODE>
DI void transpose_weights(const float* __restrict__ src, int ldsrc, u16* __restrict__ dst, int ntn, const float* __restrict__ scale, float* tile) {
  const int tid = threadIdx.x;
  for (int u = blockIdx.x; u < ntn * 32; u += gridDim.x) {
    const int tnn = u >> 5, tk = u & 31;
    {
      const int c = tid & 63, r0 = tid >> 6;
      const int n = tnn * 64 + c;
      int sc;
      if (MODE == 0) sc = n;
      else sc = (n < 3072) ? n : (n < 6144 ? n + 16 : (n < 6160 ? 3072 + (n - 6144) : -1));
#pragma unroll
      for (int i = 0; i < 16; ++i) {
        const int r = r0 + 4 * i, k = tk * 64 + r;
        float v = 0.f;
        if (sc >= 0) { v = src[(size_t)k * ldsrc + sc]; if (scale) v *= scale[k]; }
        tile[r * 65 + c] = v;
      }
    }
    __syncthreads();
    {
      const int k2 = (tid & 31) * 2, n0 = tid >> 5;
#pragma unroll
      for (int i = 0; i < 8; ++i) {
        const int n = n0 + 8 * i;
        const unsigned w = pk2(tile[k2 * 65 + n], tile[(k2 + 1) * 65 + n]);
        *(unsigned*)(dst + (size_t)(tnn * 64 + n) * 2048 + tk * 64 + k2) = w;
      }
    }
    __syncthreads();
  }
}

DI void convert_f32_bf16(const float* __restrict__ src, u16* __restrict__ dst, size_t n4) {
  const size_t stride = (size_t)gridDim.x * 256;
  for (size_t i = (size_t)blockIdx.x * 256 + threadIdx.x; i < n4; i += stride) {
    const float4 v = ((const float4*)src)[i];
    u32x2 w; w.x = pk2(v.x, v.y); w.y = pk2(v.z, v.w);
    ((u32x2*)dst)[i] = w;
  }
}


DI float wave_max(float v) {
  v = fmaxf(v, __shfl_xor(v, 32)); v = fmaxf(v, __shfl_xor(v, 16)); v = fmaxf(v, __shfl_xor(v, 8)); v = fmaxf(v, __shfl_xor(v, 4)); v = fmaxf(v, __shfl_xor(v, 2)); v = fmaxf(v, __shfl_xor(v, 1)); return v;
}
typedef float f32x32 __attribute__((ext_vector_type(32)));
typedef unsigned u32x6 __attribute__((ext_vector_type(6)));
constexpr int ROWB = 1536;
DI unsigned e2m3_code(float x) {
  const float a = fabsf(x);
  const float c = a < 2.0f ? rintf(a * 8.0f) : (a < 4.0f ? 16.0f + rintf((a - 2.0f) * 4.0f) : 24.0f + rintf((a - 4.0f) * 2.0f));
  const unsigned u = (unsigned)fminf(c, 31.0f);
  return u | (x < 0.f ? 32u : 0u);
}
DI void convert_rows_fp6(const float* __restrict__ src, unsigned char* __restrict__ dst, float* __restrict__ scl) {
  const int tid = threadIdx.x, lane = tid & 63, wid = tid >> 6;
  const int gw = blockIdx.x * 4 + wid, nw = gridDim.x * 4;
  for (int row = gw; row < NEXP; row += nw) {
    f32x4 v[8]; float am = 0.f;
#pragma unroll
    for (int j = 0; j < 8; ++j) {
      v[j] = *(const f32x4*)(src + (size_t)row * DM + 256 * j + 4 * lane);
      am = fmaxf(am, fmaxf(fmaxf(fabsf(v[j][0]), fabsf(v[j][1])), fmaxf(fabsf(v[j][2]), fabsf(v[j][3]))));
    }
    am = wave_max(am);
    const float inv = am > 0.f ? 7.5f / am : 0.f;
    unsigned c[32];
#pragma unroll
    for (int j = 0; j < 8; ++j)
#pragma unroll
      for (int q = 0; q < 4; ++q) c[4 * j + q] = e2m3_code(v[j][q] * inv);
    unsigned w[6];
#pragma unroll
    for (int g = 0; g < 2; ++g) {
      const unsigned* cc = c + 16 * g;
      w[3 * g + 0] = cc[0] | (cc[1] << 6) | (cc[2] << 12) | (cc[3] << 18) | (cc[4] << 24) | (cc[5] << 30);
      w[3 * g + 1] = (cc[5] >> 2) | (cc[6] << 4) | (cc[7] << 10) | (cc[8] << 16) | (cc[9] << 22) | (cc[10] << 28);
      w[3 * g + 2] = (cc[10] >> 4) | (cc[11] << 2) | (cc[12] << 8) | (cc[13] << 14) | (cc[14] << 20) | (cc[15] << 26);
    }
    u32x2* d2 = (u32x2*)(dst + (size_t)row * ROWB + lane * 24);
    d2[0] = (u32x2){w[0], w[1]}; d2[1] = (u32x2){w[2], w[3]}; d2[2] = (u32x2){w[4], w[5]};
    if (lane == 0) scl[row] = am * (1.0f / 7.5f);
  }
}

DI void phase_prep(const Params& p, char* lds) {
  const int tid = threadIdx.x, lane = tid & 63, wid = tid >> 6;
  const int gw = blockIdx.x * 4 + wid, nw = gridDim.x * 4;
  for (int t = gw; t < T; t += nw) {
    const float4* xr = (const float4*)(p.x + (size_t)t * DM);
    float4 v[8]; float ss = 0.f;
#pragma unroll
    for (int i = 0; i < 8; ++i) { v[i] = xr[i * 64 + lane]; ss += v[i].x * v[i].x + v[i].y * v[i].y + v[i].z * v[i].z + v[i].w * v[i].w; }
    ss = wave_sum(ss);
    const float rs = rsqrtf(ss * (1.0f / DM) + EPS);
#pragma unroll
    for (int i = 0; i < 8; ++i) {
      const float4 g = ((const float4*)p.attn_gain)[i * 64 + lane];
      u32x2 w; w.x = pk2(v[i].x * rs * g.x, v[i].y * rs * g.y); w.y = pk2(v[i].z * rs * g.z, v[i].w * rs * g.w);
      *(u32x2*)(p.xn + (size_t)t * DM + (i * 64 + lane) * 4) = w;
    }
  }
  transpose_weights<1>(p.w_in, 6160, p.winT, 98, nullptr, (float*)lds);
  transpose_weights<0>(p.w_out, 2048, p.woutT, 32, nullptr, (float*)lds);
  transpose_weights<0>(p.peer_query, 2048, p.wqT, 32, p.ffn_gain, (float*)lds);
  convert_f32_bf16(p.sub_keys, p.keysb, (size_t)8 * 2 * 128 * 128 / 4);
  convert_rows_fp6(p.peer_down, p.down8, p.dscale);
  convert_rows_fp6(p.peer_up, p.up8, p.uscale);
  if (blockIdx.x == 0) { if (tid < 128) p.qkmax[tid] = 0.f; if (tid < 8) p.ctr[tid] = 0; }
  for (int i = blockIdx.x * 256 + tid; i < SEQ * 8; i += gridDim.x * 256) {
    const int s = i >> 3, f = i & 7;
    const float ang = (float)s * p.inv_freq[f];
    float sn, cs; sincos_acc(ang, sn, cs);
    p.rope[2 * i] = cs; p.rope[2 * i + 1] = sn;
  }
}

#define LAS __attribute__((address_space(3)))
template <bool SWAP, class Epi>
DI void gemm_tile(const u16* __restrict__ A, const u16* __restrict__ Bt, int tm, int tn, u16* sa, u16* sb, const Epi& epi) {
  constexpr int K = 2048, ABUF = 256 * 32, BBUF = 128 * 32, NP = SWAP ? 4 : 8, NQ = SWAP ? 8 : 4;
  const int tid = threadIdx.x, lane = tid & 63, wid = __builtin_amdgcn_readfirstlane(tid >> 6), wm = wid >> 1, wn = wid & 1, fr = lane & 15, quad = lane >> 4;
  const u16* ga = A + (size_t)(tm * 256) * K;
  const u16* gb = Bt + (size_t)(tn * 128) * K;
  int goffA[4], goffB[2];
#pragma unroll
  for (int q = 0; q < 4; ++q) { const int r = wid * 64 + q * 16 + (lane >> 2); goffA[q] = r * K + (((lane & 3) ^ ((r >> 2) & 3)) * 8); }
#pragma unroll
  for (int q = 0; q < 2; ++q) { const int r = wid * 32 + q * 16 + (lane >> 2); goffB[q] = r * K + (((lane & 3) ^ ((r >> 2) & 3)) * 8); }
  f32x4 acc[NP][NQ];
#pragma unroll
  for (int i = 0; i < NP; ++i)
#pragma unroll
    for (int j = 0; j < NQ; ++j) acc[i][j] = (f32x4){0.f, 0.f, 0.f, 0.f};
  const int swz = (quad ^ ((fr >> 2) & 3)) * 8;
  const u16* sp = SWAP ? (sb + (wn * 64 + fr) * 32 + swz) : (sa + (wm * 128 + fr) * 32 + swz);
  const u16* sq = SWAP ? (sa + (wm * 128 + fr) * 32 + swz) : (sb + (wn * 64 + fr) * 32 + swz);
  constexpr int PBUF = SWAP ? BBUF : ABUF, QBUF = SWAP ? ABUF : BBUF;
  auto issue = [&](int k0, int buf) {
#pragma unroll
    for (int q = 0; q < 4; ++q) __builtin_amdgcn_global_load_lds((const unsigned*)(ga + goffA[q] + k0), (LAS unsigned*)(sa + buf * ABUF + (wid * 64 + q * 16) * 32), 16, 0, 0);
#pragma unroll
    for (int q = 0; q < 2; ++q) __builtin_amdgcn_global_load_lds((const unsigned*)(gb + goffB[q] + k0), (LAS unsigned*)(sb + buf * BBUF + (wid * 32 + q * 16) * 32), 16, 0, 0);
  };
  issue(0, 0);
  __syncthreads();
  for (int kt = 0; kt < K / 32; ++kt) {
    const int cur = kt & 1;
    if (kt + 1 < K / 32) issue((kt + 1) * 32, cur ^ 1);
    bf16x8 pf[NP], qf[NQ];
#pragma unroll
    for (int i = 0; i < NP; ++i) pf[i] = *(const bf16x8*)(sp + cur * PBUF + 16 * i * 32);
#pragma unroll
    for (int j = 0; j < NQ; ++j) qf[j] = *(const bf16x8*)(sq + cur * QBUF + 16 * j * 32);
    __builtin_amdgcn_s_setprio(1);
#pragma unroll
    for (int i = 0; i < NP; ++i)
#pragma unroll
      for (int j = 0; j < NQ; ++j) acc[i][j] = MFMA16(pf[i], qf[j], acc[i][j]);
    __builtin_amdgcn_s_setprio(0);
    __syncthreads();
  }
  epi.template run<SWAP>(acc, tm, tn, wm, wn, fr, quad);
}

DI float log_sigmoid(float v) { return v >= 0.f ? -log1pf(expf(-v)) : v - log1pf(expf(v)); }

DI u32x4 pair16(u32x2 e, u32x2 o, int quad, int ip, int* col) {
  const bool odd = quad & 1;
  const u32x2 send = odd ? e : o, keep = odd ? o : e;
  u32x2 recv; recv.x = (unsigned)__shfl_xor((int)send.x, 16); recv.y = (unsigned)__shfl_xor((int)send.y, 16);
  *col = 16 * (2 * ip + (odd ? 1 : 0)) + 8 * (quad >> 1);
  return odd ? (u32x4){recv.x, recv.y, keep.x, keep.y} : (u32x4){keep.x, keep.y, recv.x, recv.y};
}

struct EpiQKV {
  const Params* p;
  template <bool SWAP>
  DI void run(const f32x4 (&acc)[SWAP ? 4 : 8][SWAP ? 8 : 4], int tm, int tn, int wm, int wn, int fr, int quad) const {
    const Params& P = *p;
    const int gcol = tn * 128 + wn * 64, grp = gcol >> 10, head = (gcol & 1023) >> 6;
    const int m0 = tm * 256 + wm * 128, b = m0 >> 13, s0 = m0 & 8191, bh = b * NH + head;
    if constexpr (!SWAP) {
#pragma unroll
      for (int i = 0; i < 8; ++i)
#pragma unroll
        for (int j = 0; j < 4; ++j) {
          u32x2 w; w.x = pk2(acc[i][j][0], acc[i][j][1]); w.y = pk2(acc[i][j][2], acc[i][j][3]);
          *(u32x2*)(P.fvt + ((size_t)(bh * 64 + 16 * j + fr)) * SEQ + s0 + 16 * i + quad * 4) = w;
        }
    } else {
      if (grp == 6) {
        if (wn == 0) {
#pragma unroll
          for (int j = 0; j < 8; ++j)
#pragma unroll
            for (int r = 0; r < 4; ++r) {
              const int h = quad * 4 + r;
              const float v = acc[0][j][r] + P.forget_bias[h];
              P.logf[(size_t)(b * NH + h) * SEQ + s0 + 16 * j + fr] = log_sigmoid(v) * LOG2E;
            }
        }
      } else {
        u16* dst = grp == 0 ? P.fq : (grp == 1 ? P.fk : (grp == 3 ? P.dq : (grp == 4 ? P.dk : P.dv)));
        const float scale = (grp == 0 || grp == 3) ? 0.125f * LOG2E : 1.0f;
        const bool rope = (grp == 3 || grp == 4);
        float best = 0.f;
#pragma unroll
        for (int j = 0; j < 8; ++j) {
          const int s = s0 + 16 * j + fr;
          float nrm = 0.f;
          u32x2 pc[4];
#pragma unroll
          for (int i = 0; i < 4; ++i) {
            f32x4 v = acc[i][j];
            if (i == 0 && rope) {
              const f32x4* rp = (const f32x4*)(P.rope + ((size_t)s * 8 + (quad & 1) * 4) * 2);
              const f32x4 cs01 = rp[0], cs23 = rp[1];
              const float cs[4] = {cs01[0], cs01[2], cs23[0], cs23[2]};
              const float sn[4] = {cs01[1], cs01[3], cs23[1], cs23[3]};
#pragma unroll
              for (int r = 0; r < 4; ++r) {
                const float pr = __shfl_xor(v[r], 32);
                v[r] = quad < 2 ? v[r] * cs[r] - pr * sn[r] : v[r] * cs[r] + pr * sn[r];
              }
            }
            v *= scale;
            nrm += v[0] * v[0] + v[1] * v[1] + v[2] * v[2] + v[3] * v[3];
            pc[i].x = pk2(v[0], v[1]); pc[i].y = pk2(v[2], v[3]);
          }
#pragma unroll
          for (int ip = 0; ip < 2; ++ip) {
            int col; const u32x4 w = pair16(pc[2 * ip], pc[2 * ip + 1], quad, ip, &col);
            *(u32x4*)(dst + ((size_t)bh * SEQ + s) * 64 + col) = w;
          }
          if (grp < 2) { nrm += __shfl_xor(nrm, 16); nrm += __shfl_xor(nrm, 32); best = fmaxf(best, nrm); }
        }
        if (grp < 2) {
          best = fmaxf(best, __shfl_xor(best, 1)); best = fmaxf(best, __shfl_xor(best, 2)); best = fmaxf(best, __shfl_xor(best, 4)); best = fmaxf(best, __shfl_xor(best, 8));
          if ((threadIdx.x & 63) == 0) atomicMax((unsigned*)P.qkmax + grp * 64 + bh, __float_as_uint(best));
        }
      }
    }
  }
};

struct EpiOut {
  const Params* p;
  template <bool SWAP>
  DI void run(const f32x4 (&acc)[4][8], int tm, int tn, int wm, int wn, int fr, int quad) const {
    static_assert(SWAP, "swapped form only");
    const Params& P = *p;
    const int n0 = tn * 128 + wn * 64, m0 = tm * 256 + wm * 128;
#pragma unroll
    for (int j = 0; j < 8; ++j) {
      const int t = m0 + 16 * j + fr;
      float ss = 0.f;
      u32x2 hb[4]; f32x4 hf[4];
#pragma unroll
      for (int i = 0; i < 4; ++i) {
        const size_t off = (size_t)t * DM + n0 + 16 * i + quad * 4;
        const f32x4 xv = *(const f32x4*)(P.x + off);
        const f32x4 hv = xv + acc[i][j];
        hf[i] = hv;
        hb[i].x = pk2(hv[0], hv[1]); hb[i].y = pk2(hv[2], hv[3]);
        ss += hv[0] * hv[0] + hv[1] * hv[1] + hv[2] * hv[2] + hv[3] * hv[3];
      }
#pragma unroll
      for (int ip = 0; ip < 2; ++ip) {
        const bool odd = quad & 1;
        const f32x4 send = odd ? hf[2 * ip] : hf[2 * ip + 1], keep = odd ? hf[2 * ip + 1] : hf[2 * ip];
        f32x4 recv;
#pragma unroll
        for (int c = 0; c < 4; ++c) recv[c] = __shfl_xor(send[c], 16);
        float* dstp = P.out + (size_t)t * DM + n0 + 16 * (2 * ip + (odd ? 1 : 0)) + 8 * (quad >> 1);
        *(f32x4*)dstp = odd ? recv : keep;
        *(f32x4*)(dstp + 4) = odd ? keep : recv;
      }
#pragma unroll
      for (int ip = 0; ip < 2; ++ip) {
        int col; const u32x4 w = pair16(hb[2 * ip], hb[2 * ip + 1], quad, ip, &col);
        *(u32x4*)(P.h1bf + (size_t)t * DM + n0 + col) = w;
      }
      ss += __shfl_xor(ss, 16); ss += __shfl_xor(ss, 32);
      if (quad == 0) P.part2[(size_t)t * 32 + tn * 2 + wn] = ss;
    }
  }
};

struct EpiPQ {
  const Params* p;
  template <bool SWAP>
  DI void run(const f32x4 (&acc)[4][8], int tm, int tn, int wm, int wn, int fr, int quad) const {
    static_assert(SWAP, "swapped form only");
    const Params& P = *p;
    const int n0 = tn * 128 + wn * 64, m0 = tm * 256 + wm * 128;
#pragma unroll
    for (int j = 0; j < 8; ++j) {
      const int t = m0 + 16 * j + fr;
#pragma unroll
      for (int ip = 0; ip < 2; ++ip) {
        u32x2 e, o; e.x = pk2(acc[2 * ip][j][0], acc[2 * ip][j][1]); e.y = pk2(acc[2 * ip][j][2], acc[2 * ip][j][3]);
        o.x = pk2(acc[2 * ip + 1][j][0], acc[2 * ip + 1][j][1]); o.y = pk2(acc[2 * ip + 1][j][2], acc[2 * ip + 1][j][3]);
        int col; const u32x4 w = pair16(e, o, quad, ip, &col);
        *(u32x4*)(P.xn + (size_t)t * DM + n0 + col) = w;
      }
    }
  }
};

struct AttnLds { u16 k[3][64 * 72]; u16 v[3][64 * 72]; float cb[3][64]; float cmax[3]; float wmin[2][4]; float wq[4]; int nv; int pad[2]; };

template <bool FOX>
DI void attn_unit(const Params& P, AttnLds* L, int b, int h, int qbase, int kbase, int dstride, int kt0, int kt1, int mlo, int mhi, int pat) {
  const int tid = threadIdx.x, lane = tid & 63, wid = tid >> 6, fr = lane & 15, quad = lane >> 4;
  const int bh = b * NH + h;
  const u16* qptr = (FOX ? P.fq : P.dq) + (size_t)bh * SEQ * 64;
  const u16* kptr = (FOX ? P.fk : P.dk) + (size_t)bh * SEQ * 64;
  const u16* vptr = FOX ? (P.fvt + (size_t)bh * 64 * SEQ) : (P.dv + (size_t)bh * SEQ * 64);
  const float* lfp = P.logf + (size_t)bh * SEQ;
  float bq = 0.f;
  bf16x8 qf[2][2];
#pragma unroll
  for (int qs = 0; qs < 2; ++qs)
#pragma unroll
    for (int ks = 0; ks < 2; ++ks) {
      const int pos = qbase + (32 * wid + 16 * qs + fr) * dstride;
      qf[qs][ks] = *(const bf16x8*)(qptr + (size_t)pos * 64 + 32 * ks + quad * 8);
    }
  float mrow[2] = {-INFINITY, -INFINITY};
  f32x4 lacc[2] = {(f32x4){0.f, 0.f, 0.f, 0.f}, (f32x4){0.f, 0.f, 0.f, 0.f}};
  const bf16x8 ones = {0x3F80, 0x3F80, 0x3F80, 0x3F80, 0x3F80, 0x3F80, 0x3F80, 0x3F80};
  f32x4 o[4][2];
#pragma unroll
  for (int dt = 0; dt < 4; ++dt) { o[dt][0] = (f32x4){0.f, 0.f, 0.f, 0.f}; o[dt][1] = (f32x4){0.f, 0.f, 0.f, 0.f}; }
  float carry = 0.f;
  const int lr = tid >> 3, lc = (tid & 7) * 8;
  u32x4 rk[2], rv[2]; float rl = 0.f;
  auto gload = [&](int kt) {
#pragma unroll
    for (int i = 0; i < 2; ++i) {
      const int key = lr + 32 * i;
      const int pos = kbase + (64 * kt + key) * dstride;
      rk[i] = *(const u32x4*)(kptr + (size_t)pos * 64 + lc);
      if (FOX) rv[i] = *(const u32x4*)(vptr + (size_t)key * SEQ + 64 * kt + lc);
      else rv[i] = *(const u32x4*)(vptr + (size_t)pos * 64 + lc);
    }
    if (FOX && wid == 0) rl = lfp[64 * kt + lane];
  };
  auto sstore = [&](int buf) {
#pragma unroll
    for (int i = 0; i < 2; ++i) {
      const int key = lr + 32 * i;
      *(u32x4*)(&L->k[buf][key * 72 + lc]) = rk[i];
      if (FOX) *(u32x4*)(&L->v[buf][key * 72 + lc]) = rv[i];
      else {
        const unsigned w[4] = {rv[i][0], rv[i][1], rv[i][2], rv[i][3]};
#pragma unroll
        for (int e = 0; e < 4; ++e) {
          L->v[buf][(lc + 2 * e) * 72 + key] = (u16)(w[e] & 0xffffu);
          L->v[buf][(lc + 2 * e + 1) * 72 + key] = (u16)(w[e] >> 16);
        }
      }
    }
    if (FOX && wid == 0) {
      float v = rl;
#pragma unroll
      for (int off = 1; off < 64; off <<= 1) { const float n = __shfl_down(v, off); if (lane + off < 64) v += n; }
      L->cb[buf][lane] = carry + v - rl;
      if (lane == 0) L->cmax[buf] = carry;
      carry += __shfl(v, 0);
    }
  };
  const int count = kt1 - kt0;
  const int start = FOX ? kt1 - 1 : kt0, step = FOX ? -1 : 1;
  __syncthreads();
  gload(start); sstore(0);
  if (count > 1) gload(start + step);
  if (FOX) {
    float n2[2] = {0.f, 0.f};
#pragma unroll
    for (int qs = 0; qs < 2; ++qs)
#pragma unroll
      for (int ks = 0; ks < 2; ++ks)
#pragma unroll
        for (int e = 0; e < 8; ++e) { const float v = __uint_as_float(((unsigned)(unsigned short)qf[qs][ks][e]) << 16); n2[qs] += v * v; }
    float q2 = 0.f;
#pragma unroll
    for (int qs = 0; qs < 2; ++qs) { float v = n2[qs]; v += __shfl_xor(v, 16); v += __shfl_xor(v, 32); q2 = fmaxf(q2, v); }
    q2 = fmaxf(q2, __shfl_xor(q2, 1)); q2 = fmaxf(q2, __shfl_xor(q2, 2)); q2 = fmaxf(q2, __shfl_xor(q2, 4)); q2 = fmaxf(q2, __shfl_xor(q2, 8));
    if (lane == 0) { L->wmin[0][wid] = -INFINITY; L->wq[wid] = q2; }
  }
  __syncthreads();
  if (FOX) {
    const float q2 = fmaxf(fmaxf(L->wq[0], L->wq[1]), fmaxf(L->wq[2], L->wq[3]));
    bq = sqrtf(q2 * P.qkmax[64 + bh]) * 1.03f + 32.0f;
  }
  int bcur = 0;
  for (int it = 0; it < count; ++it) {
    const int kt = start + it * step;
    const int cur = it & 1, bnext = bcur == 2 ? 0 : bcur + 1;
    if (FOX && it >= 2) {
      const float m4 = fminf(fminf(L->wmin[cur][0], L->wmin[cur][1]), fminf(L->wmin[cur][2], L->wmin[cur][3]));
      if (bq + L->cmax[bcur] < m4) break;
    }
    if (it + 1 < count) sstore(bnext);
    if (it + 2 < count) gload(kt + 2 * step);
    const bool need_mask = FOX ? (it < 2) : true;
    const bool wave_dead = need_mask && ((64 * kt + 63 - 32 * wid) < mlo || (64 * kt - 32 * wid - 31) > mhi);
    if (!wave_dead) {
    f32x4 st[4][2];
#pragma unroll
    for (int kk = 0; kk < 4; ++kk) { st[kk][0] = (f32x4){0.f, 0.f, 0.f, 0.f}; st[kk][1] = (f32x4){0.f, 0.f, 0.f, 0.f}; }
#pragma unroll
    for (int ks = 0; ks < 2; ++ks)
#pragma unroll
      for (int kk = 0; kk < 4; ++kk) {
        const bf16x8 kf = *(const bf16x8*)(&L->k[bcur][(16 * kk + fr) * 72 + 32 * ks + quad * 8]);
        st[kk][0] = MFMA16(kf, qf[0][ks], st[kk][0]);
        st[kk][1] = MFMA16(kf, qf[1][ks], st[kk][1]);
      }
    if (FOX) {
#pragma unroll
      for (int kk = 0; kk < 4; ++kk) {
        const f32x4 cbv = *(const f32x4*)(&L->cb[bcur][16 * kk + quad * 4]);
        st[kk][0] += cbv; st[kk][1] += cbv;
      }
    }
    if (need_mask) {
#pragma unroll
      for (int kk = 0; kk < 4; ++kk)
#pragma unroll
        for (int qs = 0; qs < 2; ++qs)
#pragma unroll
          for (int r = 0; r < 4; ++r) {
            const int dlt = (64 * kt + 16 * kk + quad * 4 + r) - (32 * wid + 16 * qs + fr);
            if (dlt < mlo || dlt > mhi) st[kk][qs][r] = -INFINITY;
          }
    }
#pragma unroll
    for (int qs = 0; qs < 2; ++qs) {
      float tmax = -INFINITY;
#pragma unroll
      for (int kk = 0; kk < 4; ++kk)
#pragma unroll
        for (int r = 0; r < 4; ++r) tmax = fmaxf(tmax, st[kk][qs][r]);
      tmax = fmaxf(tmax, __shfl_xor(tmax, 16)); tmax = fmaxf(tmax, __shfl_xor(tmax, 32));
      const float mold = mrow[qs];
      const float mn = fmaxf(mold, tmax);
      const float mu = (mn == -INFINITY) ? 0.f : mn;
      mrow[qs] = mn;
      if (__builtin_amdgcn_ballot_w64(mn > mold) != 0ull) {
        const float alpha = __builtin_amdgcn_exp2f(mold - mu);
        lacc[qs] *= alpha;
#pragma unroll
        for (int dt = 0; dt < 4; ++dt) o[dt][qs] *= alpha;
      }
#pragma unroll
      for (int kk = 0; kk < 4; ++kk)
#pragma unroll
        for (int r = 0; r < 4; ++r) st[kk][qs][r] = __builtin_amdgcn_exp2f(st[kk][qs][r] - mu);
    }
#pragma unroll
    for (int ks2 = 0; ks2 < 2; ++ks2) {
      bf16x8 pf[2];
#pragma unroll
      for (int qs = 0; qs < 2; ++qs) {
        u32x4 w;
        w.x = pk2(st[2 * ks2][qs][0], st[2 * ks2][qs][1]); w.y = pk2(st[2 * ks2][qs][2], st[2 * ks2][qs][3]);
        w.z = pk2(st[2 * ks2 + 1][qs][0], st[2 * ks2 + 1][qs][1]); w.w = pk2(st[2 * ks2 + 1][qs][2], st[2 * ks2 + 1][qs][3]);
        pf[qs] = __builtin_bit_cast(bf16x8, w);
      }
      lacc[0] = MFMA16(ones, pf[0], lacc[0]);
      lacc[1] = MFMA16(ones, pf[1], lacc[1]);
#pragma unroll
      for (int dt = 0; dt < 4; ++dt) {
        const s16x4 lo = *(const s16x4*)(&L->v[bcur][(16 * dt + fr) * 72 + 32 * ks2 + quad * 4]);
        const s16x4 hi = *(const s16x4*)(&L->v[bcur][(16 * dt + fr) * 72 + 32 * ks2 + 16 + quad * 4]);
        const bf16x8 vf = __builtin_shufflevector(lo, hi, 0, 1, 2, 3, 4, 5, 6, 7);
        o[dt][0] = MFMA16(vf, pf[0], o[dt][0]);
        o[dt][1] = MFMA16(vf, pf[1], o[dt][1]);
      }
    }
    }
    if (FOX) {
      float mm = fminf(mrow[0], mrow[1]);
      mm = fminf(mm, __shfl_xor(mm, 1)); mm = fminf(mm, __shfl_xor(mm, 2)); mm = fminf(mm, __shfl_xor(mm, 4)); mm = fminf(mm, __shfl_xor(mm, 8));
      if (lane == 0) L->wmin[cur ^ 1][wid] = mm;
    }
    __syncthreads();
    bcur = bnext;
  }
#pragma unroll
  for (int qs = 0; qs < 2; ++qs) {
    const float lt = lacc[qs][0];
    const float inv = 1.0f / lt;
    const int pos = qbase + (32 * wid + 16 * qs + fr) * dstride;
    const size_t t = (size_t)b * SEQ + pos;
    u16* orow = FOX ? (P.foxo + t * 1024 + h * 64) : (P.dilop + ((size_t)pat * T + t) * 1024 + h * 64);
#pragma unroll
    for (int dt = 0; dt < 4; ++dt) {
      const f32x4 v = o[dt][qs] * inv;
      u32x2 w; w.x = pk2(v[0], v[1]); w.y = pk2(v[2], v[3]);
      *(u32x2*)(orow + 16 * dt + quad * 4) = w;
    }
    if (!FOX && quad == 0) P.lse[((size_t)pat * T + t) * NH + h] = mrow[qs] + __builtin_amdgcn_logf(lt);
  }
}

DI void phase_attn(const Params& P, char* lds) {
  AttnLds* L = (AttnLds*)lds;
  const int xcd = blockIdx.x & 7;
  int nxt = 0;
  if (threadIdx.x == 0) nxt = atomicAdd(P.ctr + xcd, 1);
  for (;;) {
    if (threadIdx.x == 0) L->nv = nxt;
    __syncthreads();
    const int v = L->nv;
    if (v >= 2048) break;
    if (threadIdx.x == 0) nxt = atomicAdd(P.ctr + xcd, 1);
    if (v < 512) {
      const int qb = 63 - (v >> 3), bh = xcd * 8 + (v & 7);
      attn_unit<true>(P, L, bh >> 4, bh & 15, 128 * qb, 0, 1, 0, 2 * (qb + 1), -(1 << 28), 128 * qb, 0);
    } else {
      const int v2 = v - 512, bh = xcd * 8 + (v2 & 7), w = v2 >> 3, pat = w >> 6, rn = w & 63;
      int d, r, n;
      if (pat == 0) { d = 1; r = 0; n = rn; } else if (pat == 1) { d = 4; r = rn >> 4; n = rn & 15; } else { d = 16; r = rn >> 2; n = rn & 3; }
      attn_unit<false>(P, L, bh >> 4, bh & 15, r + d * 128 * n, r + d * 128 * (n - 1), d, n == 0 ? 2 : 0, 4, 0, 128, pat);
    }
  }
}

DI void phase_mix(const Params& P) {
  const int tid = threadIdx.x, lane = tid & 63, wid = tid >> 6;
  const int gw = blockIdx.x * 4 + wid, nw = gridDim.x * 4;
  u16* mixed = P.xn;
  for (int t = gw; t < T; t += nw) {
    const int c0 = lane * 16;
    {
      const uint4* src = (const uint4*)(P.foxo + (size_t)t * 1024 + c0);
      const uint4 a = src[0], b2 = src[1];
      const unsigned w[8] = {a.x, a.y, a.z, a.w, b2.x, b2.y, b2.z, b2.w};
      float v[16]; float ss = 0.f;
#pragma unroll
      for (int e = 0; e < 8; ++e) { v[2 * e] = bflo(w[e]); v[2 * e + 1] = bfhi(w[e]); ss += v[2 * e] * v[2 * e] + v[2 * e + 1] * v[2 * e + 1]; }
      ss = wave_sum(ss);
      const float rs = rsqrtf(ss * (1.0f / 1024.0f) + EPS);
      unsigned ow[8];
#pragma unroll
      for (int e = 0; e < 8; ++e) ow[e] = pk2(v[2 * e] * rs * P.fox_gain[c0 + 2 * e], v[2 * e + 1] * rs * P.fox_gain[c0 + 2 * e + 1]);
      uint4* dst = (uint4*)(mixed + (size_t)t * DM + c0);
      dst[0] = make_uint4(ow[0], ow[1], ow[2], ow[3]); dst[1] = make_uint4(ow[4], ow[5], ow[6], ow[7]);
    }
    {
      const int head = lane >> 2;
      float l0 = P.lse[((size_t)0 * T + t) * NH + head], l1 = P.lse[((size_t)1 * T + t) * NH + head], l2 = P.lse[((size_t)2 * T + t) * NH + head];
      const float mx = fmaxf(l0, fmaxf(l1, l2));
      float w0 = __builtin_amdgcn_exp2f(l0 - mx), w1 = __builtin_amdgcn_exp2f(l1 - mx), w2 = __builtin_amdgcn_exp2f(l2 - mx);
      const float inv = 1.0f / (w0 + w1 + w2); w0 *= inv; w1 *= inv; w2 *= inv;
      const float wp[3] = {w0, w1, w2};
      float v[16];
#pragma unroll
      for (int e = 0; e < 16; ++e) v[e] = 0.f;
#pragma unroll
      for (int pp = 0; pp < 3; ++pp) {
        const uint4* src = (const uint4*)(P.dilop + ((size_t)pp * T + t) * 1024 + c0);
        const uint4 a = src[0], b2 = src[1];
        const unsigned w[8] = {a.x, a.y, a.z, a.w, b2.x, b2.y, b2.z, b2.w};
#pragma unroll
        for (int e = 0; e < 8; ++e) { v[2 * e] += wp[pp] * bflo(w[e]); v[2 * e + 1] += wp[pp] * bfhi(w[e]); }
      }
      float ss = 0.f;
#pragma unroll
      for (int e = 0; e < 16; ++e) ss += v[e] * v[e];
      ss = wave_sum(ss);
      const float rs = rsqrtf(ss * (1.0f / 1024.0f) + EPS);
      unsigned ow[8];
#pragma unroll
      for (int e = 0; e < 8; ++e) ow[e] = pk2(v[2 * e] * rs * P.dil_gain[c0 + 2 * e], v[2 * e + 1] * rs * P.dil_gain[c0 + 2 * e + 1]);
      uint4* dst = (uint4*)(mixed + (size_t)t * DM + 1024 + c0);
      dst[0] = make_uint4(ow[0], ow[1], ow[2], ow[3]); dst[1] = make_uint4(ow[4], ow[5], ow[6], ow[7]);
    }
  }
}

struct TopkLds { int ix[16 * 32]; };

DI unsigned f2key(float f) { const unsigned u = __float_as_uint(f); return u ^ ((unsigned)((int)u >> 31) | 0x80000000u); }
DI float key2f(unsigned k) { const unsigned u = (k & 0x80000000u) ? (k ^ 0x80000000u) : ~k; return __uint_as_float(u); }
DI unsigned umax(unsigned a, unsigned b) { return a > b ? a : b; }
DI unsigned umin(unsigned a, unsigned b) { return a < b ? a : b; }

DI void sort16_desc(unsigned (&k)[16]) {
#pragma unroll
  for (int size = 2; size <= 16; size <<= 1)
#pragma unroll
    for (int stride = size >> 1; stride > 0; stride >>= 1)
#pragma unroll
      for (int i = 0; i < 16; ++i) {
        const int l = i ^ stride;
        if (l > i) {
          const bool desc = ((i & size) == 0);
          const unsigned a = k[i], b = k[l];
          const unsigned mx = umax(a, b), mn = umin(a, b);
          k[i] = desc ? mx : mn; k[l] = desc ? mn : mx;
        }
      }
}
DI void merge_top16(unsigned (&a)[16], const unsigned (&b)[16]) {
#pragma unroll
  for (int i = 0; i < 16; ++i) a[i] = umax(a[i], b[15 - i]);
#pragma unroll
  for (int stride = 8; stride > 0; stride >>= 1)
#pragma unroll
    for (int i = 0; i < 16; ++i) {
      const int l = i ^ stride;
      if (l > i) { const unsigned x = a[i], y = a[l]; a[i] = umax(x, y); a[l] = umin(x, y); }
    }
}
DI void xquad_top16(unsigned (&a)[16]) {
#pragma unroll
  for (int off = 16; off <= 32; off <<= 1) {
    unsigned b[16];
#pragma unroll
    for (int i = 0; i < 16; ++i) b[i] = (unsigned)__shfl_xor((int)a[i], off);
    merge_top16(a, b);
  }
}
constexpr int cand_ci(int c) { int n = 0; for (int ci = 0; ci < 16; ++ci) for (int cj = 0; cj < 16; ++cj) if ((ci + 1) * (cj + 1) <= 16) { if (n == c) return ci; ++n; } return 0; }
constexpr int cand_cj(int c) { int n = 0; for (int ci = 0; ci < 16; ++ci) for (int cj = 0; cj < 16; ++cj) if ((ci + 1) * (cj + 1) <= 16) { if (n == c) return cj; ++n; } return 0; }

DI void phase_topk(const Params& P, char* lds) {
  const int tid = threadIdx.x, lane = tid & 63, wid = tid >> 6, fr = lane & 15, quad = lane >> 4;
  const int h = blockIdx.x & 7;
  u16* kl = (u16*)lds;
  for (int idx = tid; idx < 4096; idx += 256) {
    const int row = idx >> 4, c = idx & 15;
    const u32x4 v = *(const u32x4*)(P.keysb + ((size_t)h * 256 + row) * 128 + c * 8);
    *(u32x4*)(kl + row * 128 + ((c ^ (row & 15)) * 8)) = v;
  }
  __syncthreads();
  TopkLds* L = (TopkLds*)(lds + 65536 + wid * sizeof(TopkLds));
  const u16* qp = P.xn;
  const int gstep = (gridDim.x >> 3) * 4;
  for (int g = (blockIdx.x >> 3) * 4 + wid; g < T / 16; g += gstep) {
    const int t0 = g * 16;
    float rs;
    {
      const f32x4* pp = (const f32x4*)(P.part2 + (size_t)(t0 + fr) * 32);
      float ss = 0.f;
#pragma unroll
      for (int i = 0; i < 8; ++i) { const f32x4 v = pp[i]; ss += (v[0] + v[1]) + (v[2] + v[3]); }
      rs = rsqrtf(ss * (1.0f / DM) + EPS);
    }
    float av[2][16];
#pragma unroll
    for (int pp = 0; pp < 2; ++pp) {
      bf16x8 qf[4];
#pragma unroll
      for (int ks = 0; ks < 4; ++ks) qf[ks] = *(const bf16x8*)(qp + (size_t)(t0 + fr) * DM + h * 256 + pp * 128 + ks * 32 + quad * 8);
      unsigned klo[16], khi[16];
#pragma unroll
      for (int nt = 0; nt < 8; ++nt) {
        f32x4 acc = {0.f, 0.f, 0.f, 0.f};
#pragma unroll
        for (int ks = 0; ks < 4; ++ks) {
          const bf16x8 kf = *(const bf16x8*)(kl + (pp * 128 + nt * 16 + fr) * 128 + (((ks * 4 + quad) ^ fr) * 8));
          acc = MFMA16(kf, qf[ks], acc);
        }
#pragma unroll
        for (int r = 0; r < 4; ++r) {
          const unsigned key = (f2key(acc[r] * rs) & ~127u) | (unsigned)(127 - (16 * nt + quad * 4 + r));
          if (nt < 4) klo[nt * 4 + r] = key; else khi[(nt - 4) * 4 + r] = key;
        }
      }
      sort16_desc(klo); sort16_desc(khi);
      merge_top16(klo, khi);
      xquad_top16(klo);
#pragma unroll
      for (int i = 0; i < 16; ++i) av[pp][i] = key2f(klo[i] & ~127u);
      if (quad == 0) {
#pragma unroll
        for (int i = 0; i < 16; i += 4)
          *(int4*)(&L->ix[fr * 32 + pp * 16 + i]) = make_int4(127 - (int)(klo[i] & 127u), 127 - (int)(klo[i + 1] & 127u), 127 - (int)(klo[i + 2] & 127u), 127 - (int)(klo[i + 3] & 127u));
      }
    }
    unsigned ck[16];
#pragma unroll
    for (int s = 0; s < 16; ++s) {
      if (s < 13) {
        float v[4]; unsigned code[4];
#pragma unroll
        for (int q = 0; q < 4; ++q) {
          const int c = 4 * s + q;
          if (c < 50) { v[q] = av[0][cand_ci(c)] + av[1][cand_cj(c)]; code[q] = 255u - (unsigned)(cand_ci(c) * 16 + cand_cj(c)); }
          else { v[q] = -INFINITY; code[q] = 0u; }
        }
        const float vs = quad == 0 ? v[0] : (quad == 1 ? v[1] : (quad == 2 ? v[2] : v[3]));
        const unsigned cs = quad == 0 ? code[0] : (quad == 1 ? code[1] : (quad == 2 ? code[2] : code[3]));
        ck[s] = (f2key(vs) & ~255u) | cs;
        if (4 * s + 3 >= 50) { if (4 * s + quad >= 50) ck[s] = 0u; }
      } else ck[s] = 0u;
    }
    sort16_desc(ck);
    xquad_top16(ck);
    asm volatile("s_waitcnt lgkmcnt(0)" ::: "memory");
    float gv[16]; int ev[16];
    float sum = 0.f;
    const float mx0 = key2f(ck[0] & ~255u);
#pragma unroll
    for (int k = 0; k < 16; ++k) {
      gv[k] = expf(key2f(ck[k] & ~255u) - mx0); sum += gv[k];
      const int flat = 255 - (int)(ck[k] & 255u);
      ev[k] = L->ix[fr * 32 + (flat >> 4)] * 128 + L->ix[fr * 32 + 16 + (flat & 15)];
    }
    const float inv = 1.0f / sum;
    if (quad == 0) {
      const size_t ob = (size_t)(t0 + fr) * 128 + h * 16;
#pragma unroll
      for (int k = 0; k < 16; k += 4) {
        *(int4*)(P.experts + ob + k) = make_int4(ev[k], ev[k + 1], ev[k + 2], ev[k + 3]);
        *(float4*)(P.gates + ob + k) = make_float4(gv[k] * inv, gv[k + 1] * inv, gv[k + 2] * inv, gv[k + 3] * inv);
      }
    }
    asm volatile("s_waitcnt lgkmcnt(0)" ::: "memory");
  }
}

DI float gelu_tanh(float x) { return 0.5f * x * (1.0f + tanhf(0.7978845608028654f * (x + 0.044715f * x * x * x))); }

DI f32x32 load_row_fp6(const unsigned char* tab, int e, int lane) {
  const u32x2* rp = (const u32x2*)(tab + (size_t)e * ROWB + lane * 24);
  const u32x2 a = rp[0], b = rp[1], c = rp[2];
  const u32x6 w = {a[0], a[1], b[0], b[1], c[0], c[1]};
  return __builtin_amdgcn_cvt_scalef32_pk32_f32_fp6(w, 1.0f);
}

DI void phase_peer(const Params& P, char* lds) {
  const int tid = threadIdx.x, lane = tid & 63, wid = tid >> 6;
  f32x4* stash = (f32x4*)(lds + wid * 8192);
  const int gw = blockIdx.x * 4 + wid, nw = gridDim.x * 4;
  for (int t = gw; t < T; t += nw) {
    int lo4 = lane * 4; asm volatile("" : "+v"(lo4));
    float hn[32];
    {
      float hv[32]; float ss = 0.f;
#pragma unroll
      for (int j = 0; j < 8; ++j) {
        const f32x4 a = *(const f32x4*)(P.out + (size_t)t * DM + 256 * j + 4 * lane);
        stash[j * 64 + lane] = a;
        hv[4 * j + 0] = a[0]; hv[4 * j + 1] = a[1]; hv[4 * j + 2] = a[2]; hv[4 * j + 3] = a[3];
      }
#pragma unroll
      for (int e = 0; e < 32; ++e) ss += hv[e] * hv[e];
      ss = wave_sum(ss);
      const float rs = rsqrtf(ss * (1.0f / DM) + EPS);
#pragma unroll
      for (int j = 0; j < 8; ++j) {
        const f32x4 g = *(const f32x4*)(P.ffn_gain + 256 * j + lo4);
#pragma unroll
        for (int q = 0; q < 4; ++q) hn[4 * j + q] = hv[4 * j + q] * rs * g[q];
      }
    }
    const int e_lo = P.experts[(size_t)t * 128 + lane], e_hi = P.experts[(size_t)t * 128 + 64 + lane];
    const float g_lo = P.gates[(size_t)t * 128 + lane], g_hi = P.gates[(size_t)t * 128 + 64 + lane];
    const float ds_lo = P.dscale[e_lo], ds_hi = P.dscale[e_hi], us_lo = P.uscale[e_lo], us_hi = P.uscale[e_hi];
    float w_lo = 0.f, w_hi = 0.f;
    {
      float wl = 0.f, wh = 0.f;
      u32x2 b0[4][3], b1[4][3];
      auto issueA = [&](u32x2 (&buf)[4][3], int bi) {
        const int ev = (bi & 16) ? e_hi : e_lo;
#pragma unroll
        for (int u = 0; u < 4; ++u) {
          const int e = __builtin_amdgcn_readlane(ev, (bi & 15) * 4 + u);
          const u32x2* rp = (const u32x2*)(P.down8 + (size_t)e * ROWB + lane * 24);
          buf[u][0] = rp[0]; buf[u][1] = rp[1]; buf[u][2] = rp[2];
        }
      };
      auto consumeA = [&](const u32x2 (&buf)[4][3], int bi) {
#pragma unroll
        for (int u = 0; u < 4; ++u) {
          const u32x6 w = {buf[u][0][0], buf[u][0][1], buf[u][1][0], buf[u][1][1], buf[u][2][0], buf[u][2][1]};
          const f32x32 f = __builtin_amdgcn_cvt_scalef32_pk32_f32_fp6(w, 1.0f);
          float d = 0.f;
#pragma unroll
          for (int i = 0; i < 32; ++i) d += f[i] * hn[i];
          d = wave_sum(d);
          const bool mine = lane == (bi & 15) * 4 + u;
          if (mine && !(bi & 16)) wl = d;
          if (mine && (bi & 16)) wh = d;
          __builtin_amdgcn_sched_barrier(0);
        }
      };
      issueA(b0, 0);
      __builtin_amdgcn_sched_barrier(0);
#pragma unroll 1
      for (int bi = 0; bi < 32; bi += 2) {
        issueA(b1, bi + 1);
        __builtin_amdgcn_sched_barrier(0);
        consumeA(b0, bi);
        if (bi + 2 < 32) issueA(b0, bi + 2);
        __builtin_amdgcn_sched_barrier(0);
        consumeA(b1, bi + 1);
      }
      w_lo = g_lo * gelu_tanh(wl * ds_lo) * us_lo;
      w_hi = g_hi * gelu_tanh(wh * ds_hi) * us_hi;
    }
    float y[32];
#pragma unroll
    for (int e = 0; e < 32; ++e) y[e] = 0.f;
    {
      u32x2 b0[4][3], b1[4][3];
      auto issueB = [&](u32x2 (&buf)[4][3], int bi) {
        const int ev = (bi & 16) ? e_hi : e_lo;
#pragma unroll
        for (int u = 0; u < 4; ++u) {
          const int e = __builtin_amdgcn_readlane(ev, (bi & 15) * 4 + u);
          const u32x2* rp = (const u32x2*)(P.up8 + (size_t)e * ROWB + lane * 24);
          buf[u][0] = rp[0]; buf[u][1] = rp[1]; buf[u][2] = rp[2];
        }
      };
      auto consumeB = [&](const u32x2 (&buf)[4][3], int bi) {
        const float wv = (bi & 16) ? w_hi : w_lo;
#pragma unroll
        for (int u = 0; u < 4; ++u) {
          const float ws = __int_as_float(__builtin_amdgcn_readlane(__float_as_int(wv), (bi & 15) * 4 + u));
          const u32x6 w = {buf[u][0][0], buf[u][0][1], buf[u][1][0], buf[u][1][1], buf[u][2][0], buf[u][2][1]};
          const f32x32 f = __builtin_amdgcn_cvt_scalef32_pk32_f32_fp6(w, 1.0f);
#pragma unroll
          for (int i = 0; i < 32; ++i) y[i] += ws * f[i];
          __builtin_amdgcn_sched_barrier(0);
        }
      };
      issueB(b0, 0);
      __builtin_amdgcn_sched_barrier(0);
#pragma unroll 1
      for (int bi = 0; bi < 32; bi += 2) {
        issueB(b1, bi + 1);
        __builtin_amdgcn_sched_barrier(0);
        consumeB(b0, bi);
        if (bi + 2 < 32) issueB(b0, bi + 2);
        __builtin_amdgcn_sched_barrier(0);
        consumeB(b1, bi + 1);
      }
    }
    float s2 = 0.f;
    float* hp2 = P.out + (size_t)t * DM + 4 * lane; asm volatile("" : "+v"(hp2));
#pragma unroll
    for (int j = 0; j < 8; ++j) {
      const f32x4 a = stash[j * 64 + lane];
#pragma unroll
      for (int q = 0; q < 4; ++q) y[4 * j + q] += a[q];
    }
#pragma unroll
    for (int e = 0; e < 32; ++e) s2 += y[e] * y[e];
    s2 = wave_sum(s2);
    const float r2 = rsqrtf(s2 * (1.0f / DM) + EPS);
    int lo4b = lane * 4; asm volatile("" : "+v"(lo4b));
#pragma unroll
    for (int j = 0; j < 8; ++j) {
      const f32x4 g = *(const f32x4*)(P.final_gain + 256 * j + lo4b);
      f32x4 o;
#pragma unroll
      for (int q = 0; q < 4; ++q) o[q] = y[4 * j + q] * r2 * g[q];
      *(f32x4*)(hp2 + 256 * j) = o;
    }
  }
}


#define XB_TMO      128
#define XB_XCNT(j)  (256  + 64 * (j))
#define XB_XSUB(j)  (1280 + 64 * (j))
#define XB_XGEN(j)  (2304 + 64 * (j))
#define XB_TOP      3328
#define XB_TOPGEN   3392
#define XCD_BAR_WORDS 3456
#define XB_SPIN_CAP (1u << 22)

__device__ __forceinline__ unsigned xb_ld(unsigned* p)              { return __hip_atomic_load(p, __ATOMIC_RELAXED, __HIP_MEMORY_SCOPE_AGENT); }
__device__ __forceinline__ unsigned xb_add(unsigned* p, unsigned v) { return __hip_atomic_fetch_add(p, v, __ATOMIC_RELAXED, __HIP_MEMORY_SCOPE_AGENT); }
__device__ __forceinline__ unsigned xb_xcc_id() { return (unsigned)__builtin_amdgcn_s_getreg((3 << 11) | 20) & 0xFu; }
#define XB_SPIN(cond, bar) do { unsigned _sp = 0; while (cond) { __builtin_amdgcn_s_sleep(1); \
    if ((++_sp & 255u) == 0u) { if (xb_ld(&(bar)[XB_TMO])) break; if (_sp > XB_SPIN_CAP) { atomicAdd(&(bar)[XB_TMO], 1u); break; } } } } while (0)

struct XcdBarrier {
    unsigned* bar; unsigned x;
    volatile LAS unsigned* st;
};

__device__ __forceinline__ XcdBarrier xcd_barrier_post(unsigned* bar, volatile LAS unsigned* st) {
    XcdBarrier b; b.bar = bar; b.x = xb_xcc_id(); b.st = st;
    if (threadIdx.x == 0) (void)xb_add(&bar[XB_XCNT(b.x)], 1u);
    return b;
}
__device__ __forceinline__ void xcd_barrier_complete(unsigned* bar, unsigned x, unsigned& nloc, unsigned& nx) {
    const unsigned G = gridDim.x * gridDim.y * gridDim.z;
    unsigned sum, cnt, mine, sp = 0u;
    for (;;) {
        sum = 0u; cnt = 0u; mine = 0u;
#pragma unroll
        for (unsigned j = 0; j < 16; ++j) { const unsigned c = xb_ld(&bar[XB_XCNT(j)]); sum += c; cnt += (c > 0u) ? 1u : 0u; mine = (j == x) ? c : mine; }
        if (sum == G) break;
        __builtin_amdgcn_s_sleep(1);
        if ((++sp & 255u) == 0u) { if (xb_ld(&bar[XB_TMO])) break; if (sp > XB_SPIN_CAP) { atomicAdd(&bar[XB_TMO], 1u); break; } }
    }
    nloc = mine > 0u ? mine : 1u; nx = cnt > 0u ? cnt : 1u;
}

__device__ __forceinline__ void xcd_barrier(const XcdBarrier& b) {
    asm volatile("s_waitcnt vmcnt(0)" ::: "memory");
    __syncthreads();
    if (threadIdx.x == 0) {
        unsigned* bar = b.bar;
        __builtin_amdgcn_s_waitcnt(0);
        unsigned nloc = b.st[0], nx = b.st[1];
        if (nloc == 0u) { xcd_barrier_complete(bar, b.x, nloc, nx); b.st[0] = nloc; b.st[1] = nx; }
        const unsigned old = xb_add(&bar[XB_XSUB(b.x)], 1u);
        const unsigned gen = old / nloc;
        if (old + 1u == (gen + 1u) * nloc) {
            __builtin_amdgcn_fence(__ATOMIC_RELEASE, "agent");
            asm volatile("s_waitcnt vmcnt(0)" ::: "memory");
            const unsigned og = xb_add(&bar[XB_TOP], 1u);
            const unsigned tg = og / nx;
            if (og + 1u == (tg + 1u) * nx) xb_add(&bar[XB_TOPGEN], 1u);
            else XB_SPIN(xb_ld(&bar[XB_TOPGEN]) == tg, bar);
            __builtin_amdgcn_fence(__ATOMIC_ACQUIRE, "agent");
            xb_add(&bar[XB_XGEN(b.x)], 1u);
            asm volatile("s_waitcnt vmcnt(0)" ::: "memory");
        } else {
            XB_SPIN(xb_ld(&bar[XB_XGEN(b.x)]) == gen, bar);
            __builtin_amdgcn_fence(__ATOMIC_ACQUIRE, "agent");
            asm volatile("s_waitcnt vmcnt(0)" ::: "memory");
        }
    }
    __syncthreads();
}


__global__ void __launch_bounds__(256, 2) mega(Params P) {
  __shared__ __attribute__((aligned(16))) char lds[LDS_BYTES];
  cg::grid_group grid = cg::this_grid();
  const int xcd = blockIdx.x & 7, l = blockIdx.x >> 3, Lx = gridDim.x >> 3;
  u16* sa = (u16*)lds; u16* sb = sa + 2 * 256 * 32;

  if (P.out == nullptr) grid.sync();
  __shared__ uint4 xb_words;
  if (threadIdx.x == 0) xb_words = make_uint4(0u, 0u, 0u, 0u);
  __syncthreads();
  const XcdBarrier xb = xcd_barrier_post(P.xbar, (volatile LAS unsigned*)&xb_words);
  phase_prep(P, lds);
  xcd_barrier(xb);
  {
    EpiQKV epi{&P};
    for (int i = l; i < 784; i += Lx) {
      int tm, tn;
      if (i < 768) { tm = i / 6; tn = xcd * 6 + i % 6; } else { tm = xcd + 8 * (i - 768); tn = 48; }
      const int grp = (tn * 128) >> 10;
      if (grp == 2) gemm_tile<false>(P.xn, P.winT, tm, tn, sa, sb, epi); else gemm_tile<true>(P.xn, P.winT, tm, tn, sa, sb, epi);
    }
  }
  xcd_barrier(xb);
  phase_attn(P, lds);
  xcd_barrier(xb);
  phase_mix(P);
  xcd_barrier(xb);
  {
    EpiOut epi{&P};
    for (int i = l; i < 256; i += Lx) gemm_tile<true>(P.xn, P.woutT, i >> 1, xcd * 2 + (i & 1), sa, sb, epi);
  }
  xcd_barrier(xb);
  {
    EpiPQ epi{&P};
    for (int i = l; i < 256; i += Lx) gemm_tile<true>(P.h1bf, P.wqT, i >> 1, xcd * 2 + (i & 1), sa, sb, epi);
  }
  xcd_barrier(xb);
  phase_topk(P, lds);
  xcd_barrier(xb);
  phase_peer(P, lds);
}

extern "C" void kernel_launch(void* const* d_in, const int* in_sizes, int n_in, void* d_out, int out_size, void* d_ws, size_t ws_size, hipStream_t stream) {
  static int grid_blocks = 0;
  if (!grid_blocks) {
    int dev = 0, cus = 0, per_cu = 0;
    hipGetDevice(&dev);
    hipDeviceGetAttribute(&cus, hipDeviceAttributeMultiprocessorCount, dev);
    hipOccupancyMaxActiveBlocksPerMultiprocessor(&per_cu, mega, 256, 0);
    if (per_cu > 2) per_cu = 2;
    if (per_cu < 1) per_cu = 1;
    grid_blocks = cus * per_cu;
    grid_blocks &= ~7;
  }
  Params p{};
  p.x = (const float*)d_in[0]; p.attn_gain = (const float*)d_in[1]; p.w_in = (const float*)d_in[2]; p.forget_bias = (const float*)d_in[3];
  p.fox_gain = (const float*)d_in[4]; p.dil_gain = (const float*)d_in[5]; p.w_out = (const float*)d_in[6]; p.ffn_gain = (const float*)d_in[7];
  p.peer_query = (const float*)d_in[8]; p.sub_keys = (const float*)d_in[9]; p.peer_down = (const float*)d_in[10]; p.peer_up = (const float*)d_in[11];
  p.final_gain = (const float*)d_in[12];
  p.out = (float*)d_out;
  char* w = (char*)d_ws;
  size_t off = 0;
  auto take = [&](size_t bytes) { char* r = w + off; off += (bytes + 255) & ~(size_t)255; return r; };
  const size_t MB = 1024 * 1024;
  p.xn = (u16*)take(128 * MB);
  p.fq = (u16*)take(64 * MB); p.fk = (u16*)take(64 * MB); p.fvt = (u16*)take(64 * MB);
  p.dq = (u16*)take(64 * MB); p.dk = (u16*)take(64 * MB); p.dv = (u16*)take(64 * MB);
  p.h1bf = p.fq;
  p.experts = (int*)p.dq; p.gates = (float*)p.dk;
  p.foxo = (u16*)take(64 * MB); p.dilop = (u16*)take(192 * MB); p.lse = (float*)take(6 * MB);
  p.winT = (u16*)take((size_t)6272 * 2048 * 2); p.woutT = (u16*)take(8 * MB); p.wqT = (u16*)take(8 * MB);
  p.keysb = (u16*)take(512 * 1024); p.down8 = (unsigned char*)take(32 * MB); p.up8 = (unsigned char*)take(32 * MB);
  p.dscale = (float*)take(NEXP * 4); p.uscale = (float*)take(NEXP * 4);
  p.rope = (float*)take(SEQ * 8 * 2 * 4);
  p.logf = (float*)take(2 * MB); p.part2 = (float*)take(4 * MB);
  p.qkmax = (float*)take(128 * 4); p.ctr = (int*)take(8 * 4); p.xbar = (unsigned*)take(3456 * 4);
  for (int i = 0; i < 8; ++i) p.inv_freq[i] = (float)pow(500000.0, -(double)i / 8.0);
  if (off > ws_size) { fprintf(stderr, "workspace too small: need %zu have %zu\n", off, ws_size); return; }
  hipMemsetAsync(p.xbar, 0, 3456 * 4, stream);
  void* args[] = {&p};
  hipError_t e = hipLaunchCooperativeKernel((void*)mega, dim3(grid_blocks), dim3(256), args, 0, stream);
  if (e != hipSuccess) fprintf(stderr, "cooperative launch failed: %s (grid %d)\n", hipGetErrorString(e), grid_blocks);
}
```
